# Optimizing an MI355X kernel written in HIP

```python
import jax, jax.numpy as jnp
from jax import lax
import numpy as np


D_MODEL = 2048
BATCH = 2
SEQ = 4096
DEPTH = 1
DEC_BATCH = 1
DEC_SEQ = 8192
PAST_LEN = 128

CHUNK = 128
RET_HEADS = 8
RET_HEAD_DIM = 128
RET_WIDTH = RET_HEADS * RET_HEAD_DIM
SGU_GROUPS = 8
SGU_GROUP_DIM = 128
SGU_WIDTH = SGU_GROUPS * SGU_GROUP_DIM
MIX_WIDTH = RET_WIDTH + SGU_WIDTH
IN_COLS = 4 * RET_WIDTH + 2 * SGU_WIDTH
D_FF = 5632
CONV_WIDTH = 3
ROPE_BASE = 10000.0
EPS = 1e-6

kernel_name = 'hymba_gmlp_retnet_encoder'


def rms_norm(x, w):
    xf = x.astype(jnp.float32)
    y = xf * lax.rsqrt(jnp.mean(xf * xf, axis=-1, keepdims=True) + EPS)
    return (y * w.astype(jnp.float32)).astype(x.dtype)


def rotary(x):
    seq, dh = x.shape[1], x.shape[3]
    inv_freq = ROPE_BASE ** (-jnp.arange(0, dh, 2, dtype=jnp.float32) / dh)
    ang = jnp.arange(seq, dtype=jnp.float32)[:, None] * inv_freq[None, :]
    cos = jnp.cos(ang)[None, :, None, :].astype(x.dtype)
    sin = jnp.sin(ang)[None, :, None, :].astype(x.dtype)
    x1, x2 = jnp.split(x, 2, axis=-1)
    return jnp.concatenate([x1 * cos - x2 * sin, x2 * cos + x1 * sin], axis=-1)


def retention_direction(q, k, v, log_gamma, strict):
    b, h, s, dh = q.shape
    c = s // CHUNK
    qc = q.reshape(b, h, c, CHUNK, dh)
    kc = k.reshape(b, h, c, CHUNK, dh)
    vc = v.reshape(b, h, c, CHUNK, dh)
    lg = log_gamma.astype(jnp.float32)
    idx = jnp.arange(CHUNK, dtype=jnp.float32)
    diff = idx[:, None] - idx[None, :]
    mask = (diff > 0) if strict else (diff >= 0)
    dmat = jnp.where(mask[None], jnp.exp(lg[:, None, None] * jnp.maximum(diff, 0.0)[None]), 0.0).astype(q.dtype)
    zeta = jnp.exp(lg[:, None] * (CHUNK - 1 - idx)[None, :]).astype(q.dtype)
    xi = jnp.exp(lg[:, None] * (idx + 1.0)[None, :]).astype(q.dtype)
    chunk_decay = jnp.exp(lg * CHUNK).astype(q.dtype)
    scores = jnp.einsum('bhcnd,bhcmd->bhcnm', qc, kc) * dmat[None, :, None]
    inner = jnp.einsum('bhcnm,bhcme->bhcne', scores, vc)
    kv = jnp.einsum('bhcmd,bhcme->cbhde', kc * zeta[None, :, None, :, None], vc)

    def step(state, kv_c):
        return state * chunk_decay[None, :, None, None] + kv_c, state

    _, r_prev = lax.scan(step, jnp.zeros((b, h, dh, dh), kv.dtype), kv)
    cross = jnp.einsum('bhcnd,cbhde->bhcne', qc * xi[None, :, None, :, None], r_prev)
    return (inner + cross).reshape(b, h, s, dh)


def retention_mixer(q, k, v, g, log_decay_fwd, log_decay_bwd, gn_w):
    b, s, _ = q.shape
    shp = (b, s, RET_HEADS, RET_HEAD_DIM)
    qh = rotary(q.reshape(shp)) * (RET_HEAD_DIM ** -0.5)
    kh = rotary(k.reshape(shp))
    vh = v.reshape(shp)
    qh, kh, vh = (t.transpose(0, 2, 1, 3) for t in (qh, kh, vh))
    fwd = retention_direction(qh, kh, vh, log_decay_fwd, False)
    bwd = jnp.flip(retention_direction(jnp.flip(qh, 2), jnp.flip(kh, 2), jnp.flip(vh, 2), log_decay_bwd, True), 2)
    o = (fwd + bwd).transpose(0, 2, 1, 3).astype(jnp.float32)
    mu = jnp.mean(o, axis=-1, keepdims=True)
    var = jnp.mean(jnp.square(o - mu), axis=-1, keepdims=True)
    o = ((o - mu) * lax.rsqrt(var + EPS)).reshape(b, s, RET_WIDTH) * gn_w.astype(jnp.float32)
    return jax.nn.silu(g) * o.astype(q.dtype)


def spatial_gating_mixer(zu, zv, norm_w, w_s, bias):
    b, s, _ = zu.shape
    u = jax.nn.gelu(zu)
    v = rms_norm(jax.nn.gelu(zv), norm_w)
    vc = v.reshape(b, s // CHUNK, CHUNK, SGU_GROUPS, SGU_GROUP_DIM)
    sp = jnp.einsum('gnm,bcmgd->bcngd', w_s, vc) + bias.T[None, None, :, :, None]
    return u * sp.reshape(b, s, SGU_WIDTH)


def conv_ffn(h, w_up, conv_w, conv_b, w_down):
    up = h @ w_up
    pad = jnp.pad(up, ((0, 0), (1, 1), (0, 0)))
    up = pad[:, :-2] * conv_w[0] + pad[:, 1:-1] * conv_w[1] + pad[:, 2:] * conv_w[2] + conv_b
    a, bb = jnp.split(up, 2, axis=-1)
    return (jax.nn.silu(a) * bb) @ w_down


def encoder_layer(x, norm1_w, w_in, lg_fwd, lg_bwd, ret_gn_w, sgu_norm_w, sgu_w_s, sgu_b,
                  w_out, norm2_w, w_up, conv_w, conv_b, w_down):
    h = rms_norm(x, norm1_w)
    z = h @ w_in
    q, k, v, g, zu, zv = jnp.split(z, 6, axis=-1)
    ret = retention_mixer(q, k, v, g, lg_fwd, lg_bwd, ret_gn_w)
    sgu = spatial_gating_mixer(zu, zv, sgu_norm_w, sgu_w_s, sgu_b)
    x = x + jnp.concatenate([ret, sgu], axis=-1) @ w_out
    x = x + conv_ffn(rms_norm(x, norm2_w), w_up, conv_w, conv_b, w_down)
    return x


def encoder_trunk(x, layer_params, final_norm_w):
    for l in range(DEPTH):
        x = encoder_layer(x, *[p[l] for p in layer_params])
    return rms_norm(x, final_norm_w)


def setup_inputs(seed: int = 0) -> dict:
    key = jax.random.key(seed)
    ks = jax.random.split(key, 18)

    def nrm(k, shape, scale):
        return jax.random.normal(k, shape, jnp.float32) * scale

    base_ld = jnp.log(1.0 - 2.0 ** (-5.0 - jnp.arange(RET_HEADS, dtype=jnp.float32)))
    return {
        'x_prompt': nrm(ks[0], (BATCH, SEQ, D_MODEL), 1.0),
        'x_sample': nrm(ks[1], (DEC_BATCH, DEC_SEQ, D_MODEL), 1.0),
        'norm1_w': 1.0 + nrm(ks[2], (DEPTH, D_MODEL), 0.02),
        'w_in': nrm(ks[3], (DEPTH, D_MODEL, IN_COLS), D_MODEL ** -0.5),
        'ret_log_decay_fwd': base_ld[None] * (1.0 + nrm(ks[4], (DEPTH, RET_HEADS), 0.05)),
        'ret_log_decay_bwd': base_ld[None] * (1.0 + nrm(ks[5], (DEPTH, RET_HEADS), 0.05)),
        'ret_gn_w': 1.0 + nrm(ks[6], (DEPTH, RET_WIDTH), 0.02),
        'sgu_norm_w': 1.0 + nrm(ks[7], (DEPTH, SGU_WIDTH), 0.02),
        'sgu_w_s': nrm(ks[8], (DEPTH, SGU_GROUPS, CHUNK, CHUNK), CHUNK ** -0.5),
        'sgu_b': 1.0 + nrm(ks[9], (DEPTH, SGU_GROUPS, CHUNK), 0.01),
        'w_out': nrm(ks[10], (DEPTH, MIX_WIDTH, D_MODEL), MIX_WIDTH ** -0.5),
        'norm2_w': 1.0 + nrm(ks[11], (DEPTH, D_MODEL), 0.02),
        'w_up': nrm(ks[12], (DEPTH, D_MODEL, 2 * D_FF), D_MODEL ** -0.5),
        'conv_w': nrm(ks[13], (DEPTH, CONV_WIDTH, 2 * D_FF), CONV_WIDTH ** -0.5),
        'conv_b': nrm(ks[14], (DEPTH, 2 * D_FF), 0.01),
        'w_down': nrm(ks[15], (DEPTH, D_FF, D_MODEL), D_FF ** -0.5),
        'final_norm_w': 1.0 + nrm(ks[16], (D_MODEL,), 0.02),
    }


def reference(x_prompt, x_sample, norm1_w, w_in, ret_log_decay_fwd, ret_log_decay_bwd, ret_gn_w,
              sgu_norm_w, sgu_w_s, sgu_b, w_out, norm2_w, w_up, conv_w, conv_b, w_down, final_norm_w):
    layer_params = (norm1_w, w_in, ret_log_decay_fwd, ret_log_decay_bwd, ret_gn_w, sgu_norm_w,
                    sgu_w_s, sgu_b, w_out, norm2_w, w_up, conv_w, conv_b, w_down)
    y_prompt = encoder_trunk(x_prompt, layer_params, final_norm_w)
    y_sample = encoder_trunk(x_sample, layer_params, final_norm_w)
    return (y_prompt, y_sample)
```

```cpp
#include <hip/hip_runtime.h>
#include <hip/hip_cooperative_groups.h>
#include <cstdio>
#include <cstdint>
namespace cg = cooperative_groups;
namespace pg8 {
#define PG8_LAS __attribute__((address_space(3)))
typedef unsigned short bf16_t;
typedef short bf16x8 __attribute__((ext_vector_type(8)));
typedef float f32x4 __attribute__((ext_vector_type(4)));
typedef unsigned u32x4 __attribute__((ext_vector_type(4)));
constexpr int BM = 256, BK = 64, HALF = 128, HTB = HALF * BK * 2  , STAGE_BYTES = 8 * HTB, NXCD = 8, WGM = 8;

__host__ __device__ __forceinline__ int lds_byte(int r, int c) { const int st = (r >> 4) * 2 + (c >> 5), rr = r & 15, cc = c & 31, ob = rr * 64 + cc * 2; return st * 1024 + (ob ^ (((ob >> 9) & 1) << 5)); }
__host__ __device__ __forceinline__ void stage_rc(int b, int& R, int& C) { const int st = b / 1024, sb = b % 1024, swz = sb ^ (((sb >> 9) & 1) << 5); R = (st >> 1) * 16 + swz / 64; C = (st & 1) * 32 + (swz % 64) / 2; }
__host__ __device__ __forceinline__ int perm32(int rho) { const int n = rho >> 4, i = rho & 15; return 8 * (i >> 2) + 4 * n + (i & 3); }

struct Unit { int pm, pn; };
struct Gemm { const bf16_t* A; const bf16_t* Bt; int M, N, K; };

struct StaticOrder {
    int nM, nN, nwg, G, c;
    __host__ __device__ void init(int M, int N, int G_, int c_) { nM = M / BM; nN = N / BM; nwg = nM * nN; G = G_; c = c_; }
    __host__ __device__ bool next(int i, Unit& u) const {
        const long L = (long)i * G + c; if (L >= nwg) return false;
        int wgid = (int)L; { const int q = nwg / NXCD, r = nwg % NXCD, xcd = wgid % NXCD, off = wgid / NXCD; wgid = (xcd < r ? xcd * (q + 1) : r * (q + 1) + (xcd - r) * q) + off; }
        const int nig = WGM * nN, gid = wgid / nig, fm = gid * WGM, gsz = (nM - fm) < WGM ? (nM - fm) : WGM;
        u.pm = fm + ((wgid % nig) % gsz); u.pn = (wgid % nig) / gsz; return true;
    }
    __device__ __forceinline__ void a_ready(const Unit&) const {}
    __device__ __forceinline__ void done(const Unit&) const {}
};

__device__ __forceinline__ unsigned cvt_pk_bf16(float lo, float hi) { unsigned r; asm volatile("v_cvt_pk_bf16_f32 %0, %1, %2" : "=v"(r) : "v"(lo), "v"(hi)); return r; }
template <class Epi, class Sched, bool ALIGN_EPI = false, bool SP2 = false>
__device__ __forceinline__ void gemm_phase(PG8_LAS unsigned char* lds, const Gemm g, const Sched& S, const Epi& E) {
    const int tid = threadIdx.x, wid = __builtin_amdgcn_readfirstlane(tid >> 6), lane = tid & 63, wr = wid >> 2, wc = wid & 3, fr = lane & 15, fq = lane >> 4;
    const int K = g.K, nt = K / BK;
    unsigned voffA[2], voffB[2];
#pragma unroll
    for (int i = 0; i < 2; ++i) { int R, C; stage_rc(tid * 16 + i * 8192, R, C); const int Rb = Epi::PERM ? ((R & ~31) + perm32(R & 31)) : R;
        const int Ra = Epi::PERMA ? ((R & 64) + 4 * (R & 15) + ((R >> 4) & 3)) : R; voffA[i] = (unsigned)(Ra * K + C) * 2u; voffB[i] = (unsigned)(Rb * K + C) * 2u; }
    const size_t kstep = (size_t)(BK * 2);
    const size_t hstep = (size_t)HALF * K * 2;
    const size_t tstep = 2 * hstep;
    const unsigned ldsw = (unsigned)wid * 1024u;
    const int aoff = lds_byte(wr * 64 + fr, fq * 8), boff = lds_byte(wc * 32 + fr, fq * 8);
#define PG8_SA(b, h) (((b) * 2 + (h)) * HTB)
#define PG8_SB(b, h) ((4 + (b) * 2 + (h)) * HTB)
#define PG8_STAGE(bufoff, gbase, voff) do { _Pragma("unroll") for (int _i = 0; _i < 2; ++_i) \
        __builtin_amdgcn_global_load_lds((const unsigned*)((const char*)(gbase) + (voff)[_i]), (PG8_LAS unsigned*)(lds + (bufoff) + ldsw + _i * 8192), 16, 0, 0); } while (0)
#define PG8_LDA(dst, b, h) do { _Pragma("unroll") for (int m = 0; m < 4; ++m) _Pragma("unroll") for (int k = 0; k < 2; ++k) dst[m][k] = *(const PG8_LAS bf16x8*)(lds + PG8_SA(b, h) + aoff + m * 2048 + k * 1024); } while (0)
#define PG8_LDB(dst, b, h) do { _Pragma("unroll") for (int n = 0; n < 2; ++n) _Pragma("unroll") for (int k = 0; k < 2; ++k) dst[n][k] = *(const PG8_LAS bf16x8*)(lds + PG8_SB(b, h) + boff + n * 2048 + k * 1024); } while (0)
#define PG8_MMA(ai, bj, At, Bt) do { __builtin_amdgcn_s_setprio(1); _Pragma("unroll") for (int m = 0; m < 4; ++m) _Pragma("unroll") for (int n = 0; n < 2; ++n) _Pragma("unroll") for (int k = 0; k < 2; ++k) \
        acc[ai][bj][m][n] = __builtin_amdgcn_mfma_f32_16x16x32_bf16(Bt[n][k], At[m][k], acc[ai][bj][m][n], 0, 0, 0); __builtin_amdgcn_s_setprio(0); } while (0)
#define PG8_WAIT_V(n) asm volatile("s_waitcnt vmcnt(" #n ")" ::: "memory")
#define PG8_WAIT_L(n) asm volatile("s_waitcnt lgkmcnt(" #n ")" ::: "memory")
#define PG8_BAR __builtin_amdgcn_s_barrier()
#define PG8_SCHED __builtin_amdgcn_sched_barrier(0)
    Unit cur, nxt; int ui = 0;
    if (!S.next(0, cur)) return;
    f32x4 acc[2][2][4][2];
#pragma unroll
    for (int a = 0; a < 2; ++a)
#pragma unroll
        for (int b = 0; b < 2; ++b)
#pragma unroll
            for (int m = 0; m < 4; ++m)
#pragma unroll
                for (int n = 0; n < 2; ++n) acc[a][b][m][n] = (f32x4){0.f, 0.f, 0.f, 0.f};
    bf16x8 At[4][2], B0[2][2], B1[2][2];
    const char* cA = (const char*)g.A + (size_t)cur.pm * tstep; const char* cB = (const char*)g.Bt + (size_t)cur.pn * tstep;
    S.a_ready(cur);
    if constexpr (SP2) {
        PG8_STAGE(PG8_SB(0, 0), cB, voffB); PG8_STAGE(PG8_SB(0, 1), cB + hstep, voffB); PG8_STAGE(PG8_SA(0, 0), cA, voffA); PG8_STAGE(PG8_SA(0, 1), cA + hstep, voffA);
        if (wr == 1) PG8_BAR;
        PG8_WAIT_V(2); PG8_BAR;
        PG8_STAGE(PG8_SB(1, 0), cB + kstep, voffB); PG8_STAGE(PG8_SA(1, 0), cA + kstep, voffA); PG8_STAGE(PG8_SB(1, 1), cB + hstep + kstep, voffB);
        PG8_WAIT_V(6); PG8_BAR;
    } else {
        PG8_STAGE(PG8_SB(0, 0), cB, voffB); PG8_STAGE(PG8_SA(0, 0), cA, voffA); PG8_STAGE(PG8_SB(0, 1), cB + hstep, voffB); PG8_STAGE(PG8_SA(0, 1), cA + hstep, voffA);
        if (wr == 1) PG8_BAR;
        PG8_WAIT_V(4); PG8_BAR;
        PG8_STAGE(PG8_SB(1, 0), cB + kstep, voffB); PG8_STAGE(PG8_SA(1, 0), cA + kstep, voffA); PG8_STAGE(PG8_SB(1, 1), cB + hstep + kstep, voffB);
        PG8_WAIT_V(6); PG8_BAR;
    }
    for (;;) {
        const bool has_next = S.next(ui + 1, nxt);
        const char* nA = has_next ? (const char*)g.A + (size_t)nxt.pm * tstep : cA; const char* nB = has_next ? (const char*)g.Bt + (size_t)nxt.pn * tstep : cB;
        for (int t = 0; t < nt; t += 2) {
            const bool last = (t == nt - 2);
            const char* a1 = cA + (size_t)(t + 1) * kstep;
            const char* a2 = last ? nA : cA + (size_t)(t + 2) * kstep; const char* b2 = last ? nB : cB + (size_t)(t + 2) * kstep;
            const char* a3 = a2 + kstep; const char* b3 = b2 + kstep;
            if (last && has_next) S.a_ready(nxt);
            if constexpr (SP2) {
            PG8_LDB(B0, 0, 0); PG8_LDB(B1, 0, 1); PG8_SCHED; PG8_LDA(At, 0, 0); PG8_STAGE(PG8_SA(1, 1), a1 + hstep, voffA);
            PG8_WAIT_V(8); PG8_WAIT_L(0); PG8_BAR; PG8_MMA(0, 0, At, B0); PG8_MMA(0, 1, At, B1); PG8_BAR; PG8_SCHED;
            PG8_LDA(At, 0, 1); PG8_STAGE(PG8_SB(0, 0), b2, voffB); PG8_STAGE(PG8_SB(0, 1), b2 + hstep, voffB); PG8_STAGE(PG8_SA(0, 0), a2, voffA);
            PG8_WAIT_V(8); PG8_WAIT_L(0); PG8_BAR; PG8_MMA(1, 0, At, B0); PG8_MMA(1, 1, At, B1); PG8_BAR; PG8_SCHED;
            PG8_LDB(B0, 1, 0); PG8_LDB(B1, 1, 1); PG8_SCHED; PG8_LDA(At, 1, 0); PG8_STAGE(PG8_SA(0, 1), a2 + hstep, voffA);
            PG8_WAIT_V(8); PG8_WAIT_L(0); PG8_BAR; PG8_MMA(0, 0, At, B0); PG8_MMA(0, 1, At, B1); PG8_BAR; PG8_SCHED;
            PG8_LDA(At, 1, 1); PG8_STAGE(PG8_SB(1, 0), b3, voffB); PG8_STAGE(PG8_SB(1, 1), b3 + hstep, voffB); PG8_STAGE(PG8_SA(1, 0), a3, voffA);
            PG8_WAIT_V(8); PG8_WAIT_L(0); PG8_BAR; PG8_MMA(1, 0, At, B0); PG8_MMA(1, 1, At, B1); PG8_BAR; PG8_SCHED;
            } else {
            PG8_LDB(B0, 0, 0); PG8_SCHED; PG8_LDA(At, 0, 0); PG8_STAGE(PG8_SA(1, 1), a1 + hstep, voffA);
            PG8_WAIT_L(8); PG8_BAR; PG8_WAIT_L(0); PG8_MMA(0, 0, At, B0); PG8_BAR; PG8_SCHED;
            PG8_LDB(B1, 0, 1); PG8_STAGE(PG8_SB(0, 0), b2, voffB);
            PG8_BAR; PG8_WAIT_L(0); PG8_MMA(0, 1, At, B1); PG8_BAR;
            PG8_LDA(At, 0, 1); PG8_STAGE(PG8_SA(0, 0), a2, voffA);
            PG8_BAR; PG8_WAIT_L(0); PG8_MMA(1, 0, At, B0); PG8_BAR; PG8_SCHED;
            PG8_STAGE(PG8_SB(0, 1), b2 + hstep, voffB);
            PG8_WAIT_V(6); PG8_BAR; PG8_MMA(1, 1, At, B1); PG8_BAR;
            PG8_LDB(B0, 1, 0); PG8_SCHED; PG8_LDA(At, 1, 0); PG8_STAGE(PG8_SA(0, 1), a2 + hstep, voffA);
            PG8_WAIT_L(8); PG8_BAR; PG8_WAIT_L(0); PG8_MMA(0, 0, At, B0); PG8_BAR; PG8_SCHED;
            PG8_LDB(B1, 1, 1); PG8_STAGE(PG8_SB(1, 0), b3, voffB);
            PG8_BAR; PG8_WAIT_L(0); PG8_MMA(0, 1, At, B1); PG8_BAR;
            PG8_LDA(At, 1, 1); PG8_STAGE(PG8_SA(1, 0), a3, voffA);
            PG8_BAR; PG8_WAIT_L(0); PG8_MMA(1, 0, At, B0); PG8_BAR; PG8_SCHED;
            PG8_STAGE(PG8_SB(1, 1), b3 + hstep, voffB);
            PG8_WAIT_V(6); PG8_BAR; PG8_MMA(1, 1, At, B1); PG8_BAR;
            }
        }
        if constexpr (ALIGN_EPI) { if (wr == 0) PG8_BAR; }
        if constexpr (!Epi::AFTER_DRAIN) { E(acc, cur, wr, wc, fr, fq); S.done(cur); }
        if (!has_next) break;
#pragma unroll
        for (int a = 0; a < 2; ++a)
#pragma unroll
            for (int b = 0; b < 2; ++b)
#pragma unroll
                for (int m = 0; m < 4; ++m)
#pragma unroll
                    for (int n = 0; n < 2; ++n) acc[a][b][m][n] = (f32x4){0.f, 0.f, 0.f, 0.f};
        cur = nxt; cA = nA; cB = nB; ++ui;
        if constexpr (ALIGN_EPI) { if (wr == 1) PG8_BAR; }
    }
    PG8_WAIT_V(0);
    if constexpr (!ALIGN_EPI) { if (wr == 0) PG8_BAR; }
    PG8_BAR;
    if constexpr (Epi::AFTER_DRAIN) { E.fused(acc, cur, wr, wc, fr, fq, lds, wid, lane); S.done(cur); }
#undef PG8_SA
#undef PG8_SB
#undef PG8_STAGE
#undef PG8_LDA
#undef PG8_LDB
#undef PG8_MMA
#undef PG8_WAIT_V
#undef PG8_WAIT_L
#undef PG8_BAR
#undef PG8_SCHED
}
}

#ifndef PH_MASK
#define PH_MASK 0x1ff
#endif
#define DI __device__ __forceinline__
#define LAS __attribute__((address_space(3)))
using pg8::bf16_t; using pg8::bf16x8; using pg8::f32x4; using pg8::u32x4; using pg8::cvt_pk_bf16;
typedef unsigned u32x2 __attribute__((ext_vector_type(2)));

constexpr int T = 16384, DM = 2048, INC = 6144, FF = 5632, FF2 = 11264, RW = 1024;
constexpr float EPS = 1e-6f, LOG2E = 1.4426950408889634f;
constexpr size_t MiB = 1u << 20;
constexpr size_t WS_CTL = 0, WS_ROPE = 1 * MiB, WS_WOUT = 5 * MiB, WS_WUP = 13 * MiB, WS_WDOWN = 57 * MiB;
constexpr size_t WS_Z = 79 * MiB;
constexpr size_t WS_X1B = 79 * MiB;
constexpr size_t WS_ACT = 143 * MiB;
constexpr size_t WS_WIN = 271 * MiB;
constexpr size_t WS_MIX = 271 * MiB;
constexpr size_t WS_HALO = 319 * MiB;
constexpr size_t WS_RS1 = 336 * MiB, WS_SSQV = 337 * MiB, WS_SSQ2 = 338 * MiB, WS_SSQ3 = 340 * MiB, WS_END = 342 * MiB;
constexpr int RING_BYTES = 131072, EX_OFF = 131072, MISC_OFF = 139264, LDS_BYTES = 147456;
constexpr int TP = 136;

DI float silu_f(float x) { return x * __builtin_amdgcn_rcpf(1.f + __builtin_amdgcn_exp2f(-LOG2E * x)); }
DI float gelu_f(float x) { const float u = x + 0.044715f * x * x * x; return x * __builtin_amdgcn_rcpf(1.f + __builtin_amdgcn_exp2f(-2.f * 0.7978845608028654f * LOG2E * u)); }
DI float bf_lo(unsigned w) { return __uint_as_float(w << 16); }
DI float bf_hi(unsigned w) { return __uint_as_float(w & 0xffff0000u); }
DI unsigned short u16_of(const u32x4& v, int e) { const unsigned w = v[e >> 1]; return (unsigned short)((e & 1) ? (w >> 16) : (w & 0xffffu)); }
DI u32x2 pack4(const f32x4& v) { u32x2 r; r.x = cvt_pk_bf16(v[0], v[1]); r.y = cvt_pk_bf16(v[2], v[3]); return r; }
DI float sum4(const f32x4& v) { return (v[0] + v[1]) + (v[2] + v[3]); }
DI float sq4(const f32x4& v) { return (v[0] * v[0] + v[1] * v[1]) + (v[2] * v[2] + v[3] * v[3]); }
DI float wave_sum(float v) {
#pragma unroll
    for (int o = 1; o < 64; o <<= 1) v += __shfl_xor(v, o);
    return v;
}
#define LBAR() do { asm volatile("s_waitcnt lgkmcnt(0)" ::: "memory"); __builtin_amdgcn_s_barrier(); asm volatile("" ::: "memory"); } while (0)
#define MFMA16(a, b, c) __builtin_amdgcn_mfma_f32_16x16x32_bf16((a), (b), (c), 0, 0, 0)

struct EpiIn {
    static constexpr bool PERM = true, AFTER_DRAIN = false, PERMA = false;
    bf16_t* Z; const float* rs1; const float* rope; float* ssqv;
    DI void operator()(const f32x4 (&acc)[2][2][4][2], const pg8::Unit& u, int wr, int wc, int fr, int fq) const {
        const int region = u.pn >> 2;
#pragma unroll
        for (int ai = 0; ai < 2; ++ai)
#pragma unroll
            for (int m = 0; m < 4; ++m) {
                const int row = u.pm * 256 + ai * 128 + wr * 64 + m * 16 + fr;
                const float rs = rs1[row];
                bf16_t* zr = Z + (size_t)row * INC;
                if (region < 2) {
                    const int pos = row < 4096 ? row : (row < 8192 ? row - 4096 : row - 8192);
                    const f32x4* rp = (const f32x4*)(rope + ((size_t)pos * 64 + 16 * wc + 4 * fq) * 2);
                    const f32x4 cs0 = rp[0], cs1 = rp[1];
#pragma unroll
                    for (int bj = 0; bj < 2; ++bj) {
                        const f32x4 x1 = acc[ai][bj][m][0] * rs, x2 = acc[ai][bj][m][1] * rs;
                        f32x4 o1, o2;
                        o1[0] = x1[0] * cs0[0] - x2[0] * cs0[1]; o2[0] = x2[0] * cs0[0] + x1[0] * cs0[1];
                        o1[1] = x1[1] * cs0[2] - x2[1] * cs0[3]; o2[1] = x2[1] * cs0[2] + x1[1] * cs0[3];
                        o1[2] = x1[2] * cs1[0] - x2[2] * cs1[1]; o2[2] = x2[2] * cs1[0] + x1[2] * cs1[1];
                        o1[3] = x1[3] * cs1[2] - x2[3] * cs1[3]; o2[3] = x2[3] * cs1[2] + x1[3] * cs1[3];
                        const int col = region * 1024 + ((u.pn & 3) * 2 + bj) * 128 + 16 * wc + 4 * fq;
                        *(u32x2*)(zr + col) = pack4(o1); *(u32x2*)(zr + col + 64) = pack4(o2);
                    }
                } else {
                    float ss = 0.f;
#pragma unroll
                    for (int bj = 0; bj < 2; ++bj) {
                        f32x4 v0 = acc[ai][bj][m][0] * rs, v1 = acc[ai][bj][m][1] * rs;
                        if (region == 3) {
#pragma unroll
                            for (int i = 0; i < 4; ++i) { v0[i] = silu_f(v0[i]); v1[i] = silu_f(v1[i]); }
                        } else if (region >= 4) {
#pragma unroll
                            for (int i = 0; i < 4; ++i) { v0[i] = gelu_f(v0[i]); v1[i] = gelu_f(v1[i]); }
                        }
                        ss += sq4(v0) + sq4(v1);
                        u32x4 w4; w4.x = cvt_pk_bf16(v0[0], v0[1]); w4.y = cvt_pk_bf16(v0[2], v0[3]); w4.z = cvt_pk_bf16(v1[0], v1[1]); w4.w = cvt_pk_bf16(v1[2], v1[3]);
                        *(u32x4*)(zr + u.pn * 256 + bj * 128 + 32 * wc + 8 * fq) = w4;
                    }
                    if (region == 5) { ss += __shfl_xor(ss, 16); ss += __shfl_xor(ss, 32); if (fq == 0) ssqv[(size_t)row * 16 + (u.pn - 20) * 4 + wc] = ss; }
                }
            }
    }
};

template <bool DOWN> struct EpiRes {
    static constexpr bool PERM = true, AFTER_DRAIN = false, PERMA = false;
    const float* xp; const float* xs; float* X1; bf16_t* X1B; float* ssq;
    DI void operator()(const f32x4 (&acc)[2][2][4][2], const pg8::Unit& u, int wr, int wc, int fr, int fq) const {
#pragma unroll
        for (int ai = 0; ai < 2; ++ai)
#pragma unroll
            for (int m = 0; m < 4; ++m) {
                const int row = u.pm * 256 + ai * 128 + wr * 64 + m * 16 + fr;
                const float* xr = DOWN ? (const float*)(X1 + (size_t)row * DM) : (row < 8192 ? xp + (size_t)row * DM : xs + (size_t)(row - 8192) * DM);
                float ss = 0.f;
#pragma unroll
                for (int bj = 0; bj < 2; ++bj) {
                    const int col = u.pn * 256 + bj * 128 + 32 * wc + 8 * fq;
                    const f32x4 b0 = *(const f32x4*)(xr + col), b1 = *(const f32x4*)(xr + col + 4);
                    const f32x4 v0 = acc[ai][bj][m][0] + b0, v1 = acc[ai][bj][m][1] + b1;
                    ss += sq4(v0) + sq4(v1);
                    *(f32x4*)(X1 + (size_t)row * DM + col) = v0; *(f32x4*)(X1 + (size_t)row * DM + col + 4) = v1;
                    if (!DOWN) { u32x4 w4; w4.x = cvt_pk_bf16(v0[0], v0[1]); w4.y = cvt_pk_bf16(v0[2], v0[3]); w4.z = cvt_pk_bf16(v1[0], v1[1]); w4.w = cvt_pk_bf16(v1[2], v1[3]);
                        *(u32x4*)(X1B + (size_t)row * DM + col) = w4; }
                }
                ss += __shfl_xor(ss, 16); ss += __shfl_xor(ss, 32);
                if (fq == 0) ssq[(size_t)row * 32 + u.pn * 4 + wc] = ss;
            }
    }
};

struct EpiUp {
    static constexpr bool PERM = true, AFTER_DRAIN = false, PERMA = true;
    bf16_t* ACT; float* HALO; const float* ssq2; const float* convw; const float* convb; LAS float* ex;
    DI void operator()(const f32x4 (&acc)[2][2][4][2], const pg8::Unit& u, int wr, int wc, int fr, int fq) const {
        asm volatile("" : "+v"(fr), "+v"(fq));
        asm volatile("" : "+s"(wr), "+s"(wc));
        const int lane = fq * 16 + fr;
        const int tcol = 32 * wc + 8 * fq;
        float rs[2][4];
#pragma unroll
        for (int ai = 0; ai < 2; ++ai) {
#pragma unroll
            for (int m = 0; m < 4; ++m) {
                const int row = u.pm * 256 + ai * 128 + wr * 64 + 4 * fr + m;
                const f32x4* p = (const f32x4*)(ssq2 + (size_t)row * 32 + fq * 8);
                float s = sum4(p[0]) + sum4(p[1]);
                s += __shfl_xor(s, 16); s += __shfl_xor(s, 32);
                rs[ai][m] = rsqrtf(s * (1.0f / DM) + EPS);
            }
            const int b = 2 * ai + wr;
            if (fr == 0 || fr == 15) {
                const bool lo = fr == 0;
#pragma unroll
                for (int bj = 0; bj < 2; ++bj)
#pragma unroll
                    for (int n = 0; n < 2; ++n) {
                        const f32x4 a0 = acc[ai][bj][0][n] * rs[ai][0], a3 = acc[ai][bj][3][n] * rs[ai][3];
                        f32x4 val; val[0] = lo ? a0[0] : a3[0]; val[1] = lo ? a0[1] : a3[1]; val[2] = lo ? a0[2] : a3[2]; val[3] = lo ? a0[3] : a3[3];
                        *(LAS f32x4*)(ex + (b * 2 + (lo ? 0 : 1)) * 256 + bj * 128 + tcol + 4 * n) = val;
                    }
            }
        }
        {
            const bool hfirst = (wr == 0 && fr == 0), hlast = (wr == 1 && fr == 15);
            if (hfirst || hlast) {
#pragma unroll
                for (int k = 0; k < 2; ++k)
#pragma unroll
                    for (int bj = 0; bj < 2; ++bj)
#pragma unroll
                        for (int n = 0; n < 2; ++n) {
                            const f32x4 a0 = acc[0][bj][k][n] * rs[0][k], a1 = acc[1][bj][2 + k][n] * rs[1][2 + k];
                            f32x4 val; val[0] = hfirst ? a0[0] : a1[0]; val[1] = hfirst ? a0[1] : a1[1]; val[2] = hfirst ? a0[2] : a1[2]; val[3] = hfirst ? a0[3] : a1[3];
                            *(f32x4*)(HALO + (size_t)(u.pm * 4 + (hfirst ? k : 2 + k)) * FF2 + u.pn * 256 + bj * 128 + tcol + 4 * n) = val;
                        }
            }
        }
        LBAR();
        const int src_dn = (lane & 48) | ((fr + 15) & 15), src_up = (lane & 48) | ((fr + 1) & 15);
#pragma unroll
        for (int ai = 0; ai < 2; ++ai) {
            const int b = 2 * ai + wr;
#pragma unroll
            for (int n = 0; n < 2; ++n) {
                const int ca = u.pn * 128 + tcol + 4 * n;
                float outv[4][4];
#pragma unroll
                for (int i = 0; i < 4; ++i) {
                    const float* cwp = convw + ca + i; const float* cbp = convb + ca + i;
                    float cva[4];
#pragma unroll
                    for (int bj = 0; bj < 2; ++bj) {
                        const float w0 = cwp[bj * FF], w1 = cwp[FF2 + bj * FF], w2 = cwp[2 * FF2 + bj * FF], bs = cbp[bj * FF];
                        float v[4];
#pragma unroll
                        for (int m = 0; m < 4; ++m) v[m] = acc[ai][bj][m][n][i] * rs[ai][m];
                        float prevv = __shfl(v[3], src_dn), nextv = __shfl(v[0], src_up);
                        if (fr == 0) prevv = ex[(((b > 0 ? b - 1 : 0)) * 2 + 1) * 256 + bj * 128 + tcol + 4 * n + i];
                        if (fr == 15) nextv = ex[(((b < 3 ? b + 1 : 3)) * 2 + 0) * 256 + bj * 128 + tcol + 4 * n + i];
#pragma unroll
                        for (int m = 0; m < 4; ++m) {
                            const float pv = m == 0 ? prevv : v[m > 0 ? m - 1 : 0], nv = m == 3 ? nextv : v[m < 3 ? m + 1 : 3];
                            const float cv = w0 * pv + w1 * v[m] + w2 * nv + bs;
                            if (bj == 0) cva[m] = cv; else outv[m][i] = silu_f(cva[m]) * cv;
                        }
                    }
                }
#pragma unroll
                for (int m = 0; m < 4; ++m) {
                    const int tr = ai * 128 + wr * 64 + 4 * fr + m;
                    u32x2 o; o.x = cvt_pk_bf16(outv[m][0], outv[m][1]); o.y = cvt_pk_bf16(outv[m][2], outv[m][3]);
                    if (tr != 0 && tr != 255) *(u32x2*)(ACT + (size_t)(u.pm * 256 + tr) * FF + ca) = o;
                }
                __builtin_amdgcn_sched_barrier(0);
            }
        }
    }
};

DI void p0_transpose_item(const float* W, int K, int N, bf16_t* WT, const float* kscale, int mode, LAS float* scr, int item, int lane) {
    const int nblk = N / 32, kb = item / nblk, nb = item % nblk, k0 = 64 * kb, n0 = 32 * nb;
#pragma unroll 8
    for (int i = 0; i < 32; ++i) { const int kk = 2 * i + (lane >> 5); float v = W[(size_t)(k0 + kk) * N + n0 + (lane & 31)]; if (kscale) v *= kscale[k0 + kk]; scr[kk * 33 + (lane & 31)] = v; }
    asm volatile("s_waitcnt lgkmcnt(0)" ::: "memory");
    const int c = lane & 7;
#pragma unroll
    for (int j = 0; j < 4; ++j) {
        const int n = (lane >> 3) + 8 * j, ncol = n0 + n; const LAS float* s = scr + (8 * c) * 33 + n;
        int prow = ncol; float sc = 1.f;
        if (mode == 1) { const int region = ncol >> 10; if (region < 2) { const int cc = ncol & 127; prow = (ncol & ~127) + 32 * ((cc >> 4) & 3) + 8 * ((cc >> 2) & 3) + 4 * (cc >> 6) + (cc & 3); if (region == 0) sc = 0.08838834764831845f; } }
        else if (mode == 2) { if (ncol < FF) prow = 256 * (ncol >> 7) + (ncol & 127); else { const int nn = ncol - FF; prow = 256 * (nn >> 7) + 128 + (nn & 127); } }
        u32x4 o; o.x = cvt_pk_bf16(s[0 * 33] * sc, s[1 * 33] * sc); o.y = cvt_pk_bf16(s[2 * 33] * sc, s[3 * 33] * sc); o.z = cvt_pk_bf16(s[4 * 33] * sc, s[5 * 33] * sc); o.w = cvt_pk_bf16(s[6 * 33] * sc, s[7 * 33] * sc);
        *(u32x4*)(WT + (size_t)prow * K + k0 + 8 * c) = o;
    }
    asm volatile("s_waitcnt lgkmcnt(0)" ::: "memory");
}

DI void scan_item(LAS unsigned char* lds, int item, const bf16_t* Z, float* crossF, float* crossB, const float* lgf, const float* lgb) {
    const int tid = threadIdx.x, lane = tid & 63, w = tid >> 6, fr = lane & 15, fq = lane >> 4;
    const int sidx = item >> 6, rem = item & 63, h = rem >> 3, dir = (rem >> 2) & 1, sl = rem & 3;
    const int rowbase = sidx == 0 ? 8192 : (sidx == 1 ? 0 : 4096), nch = sidx == 0 ? 64 : 32;
    const float l2g = (dir ? lgb[h] : lgf[h]) * LOG2E;
    const float decay = exp2f(l2g * 128.f);
    float* cross = dir ? crossB : crossF;
    LAS bf16_t* Qs = (LAS bf16_t*)lds; LAS bf16_t* Kt = Qs + 128 * TP; LAS bf16_t* Vst = Kt + 128 * TP; LAS bf16_t* Rt = Vst + 32 * TP;
    f32x4 racc[2]; racc[0] = (f32x4){0.f, 0.f, 0.f, 0.f}; racc[1] = racc[0];
    const int tr = tid & 127, tc = tid >> 7;
    const float zeta = exp2f(l2g * (float)(dir ? tr : 127 - tr));
    const int n = 16 * w + fr;
    const float xi = exp2f(l2g * (float)(dir ? 128 - n : n + 1));
    u32x4 qreg[4], kreg[4], vreg;
    {
        const int c0 = dir ? nch - 1 : 0; const bf16_t* zb = Z + (size_t)(rowbase + c0 * 128) * INC + h * 128;
#pragma unroll
        for (int i = 0; i < 4; ++i) { const int v = tid + 512 * i; qreg[i] = *(const u32x4*)(zb + (size_t)(v >> 4) * INC + (v & 15) * 8); kreg[i] = *(const u32x4*)(zb + (size_t)tr * INC + 1024 + (tc + 4 * i) * 8); }
        vreg = *(const u32x4*)(zb + (size_t)tr * INC + 2048 + sl * 32 + tc * 8);
    }
    for (int step = 0; step < nch; ++step) {
        const int c = dir ? nch - 1 - step : step; const int row0 = rowbase + c * 128;
#pragma unroll
        for (int i = 0; i < 4; ++i) { const int v = tid + 512 * i; *(LAS u32x4*)(Qs + (v >> 4) * TP + (v & 15) * 8) = qreg[i]; }
#pragma unroll
        for (int i = 0; i < 4; ++i)
#pragma unroll
            for (int e = 0; e < 8; ++e) Kt[((tc + 4 * i) * 8 + e) * TP + tr] = u16_of(kreg[i], e);
#pragma unroll
        for (int e = 0; e < 8; e += 2) {
            const unsigned wv = vreg[e >> 1]; const unsigned pk = cvt_pk_bf16(bf_lo(wv) * zeta, bf_hi(wv) * zeta);
            Vst[(tc * 8 + e) * TP + tr] = (unsigned short)(pk & 0xffffu); Vst[(tc * 8 + e + 1) * TP + tr] = (unsigned short)(pk >> 16);
        }
#pragma unroll
        for (int t = 0; t < 2; ++t) *(LAS u32x2*)(Rt + (16 * t + fr) * TP + 16 * w + 4 * fq) = pack4(racc[t]);
        LBAR();
        if (step + 1 < nch) {
            const int cn = dir ? nch - 2 - step : step + 1; const bf16_t* zb = Z + (size_t)(rowbase + cn * 128) * INC + h * 128;
#pragma unroll
            for (int i = 0; i < 4; ++i) { const int v = tid + 512 * i; qreg[i] = *(const u32x4*)(zb + (size_t)(v >> 4) * INC + (v & 15) * 8); kreg[i] = *(const u32x4*)(zb + (size_t)tr * INC + 1024 + (tc + 4 * i) * 8); }
            vreg = *(const u32x4*)(zb + (size_t)tr * INC + 2048 + sl * 32 + tc * 8);
        }
        bf16x8 qf[4];
#pragma unroll
        for (int ks = 0; ks < 4; ++ks) qf[ks] = *(const LAS bf16x8*)(Qs + n * TP + ks * 32 + fq * 8);
#pragma unroll
        for (int t = 0; t < 2; ++t) {
            f32x4 ca = {0.f, 0.f, 0.f, 0.f};
#pragma unroll
            for (int ks = 0; ks < 4; ++ks) { const bf16x8 rf = *(const LAS bf16x8*)(Rt + (16 * t + fr) * TP + ks * 32 + fq * 8); ca = MFMA16(rf, qf[ks], ca); }
            *(f32x4*)(cross + (size_t)(row0 + n) * RW + h * 128 + sl * 32 + 16 * t + 4 * fq) = ca * xi;
        }
        racc[0] = racc[0] * decay; racc[1] = racc[1] * decay;
#pragma unroll
        for (int ks = 0; ks < 4; ++ks) {
            const bf16x8 kf = *(const LAS bf16x8*)(Kt + n * TP + ks * 32 + fq * 8);
#pragma unroll
            for (int t = 0; t < 2; ++t) { const bf16x8 vf = *(const LAS bf16x8*)(Vst + (16 * t + fr) * TP + ks * 32 + fq * 8); racc[t] = MFMA16(kf, vf, racc[t]); }
        }
        LBAR();
    }
}

DI void sgu_item(LAS unsigned char* lds, int item, const bf16_t* Z, const float* ssqv, const float* normw, const float* w_s, const float* sgub, bf16_t* MIX) {
    const int tid = threadIdx.x, lane = tid & 63, w = tid >> 6, fr = lane & 15, fq = lane >> 4;
    const int chunk = item >> 3, g = item & 7, row0 = chunk * 128;
    LAS bf16_t* Wsl = (LAS bf16_t*)lds; LAS bf16_t* vt = Wsl + 128 * TP;
    const float* wg = w_s + (size_t)g * 16384;
#pragma unroll
    for (int i = 0; i < 8; ++i) { const int v = tid + 512 * i; const f32x4 x = *(const f32x4*)(wg + (size_t)v * 4); *(LAS u32x2*)(Wsl + (v >> 5) * TP + (v & 31) * 4) = pack4(x); }
    const int tr = tid & 127, tc = tid >> 7;
    {
        const f32x4* sp = (const f32x4*)(ssqv + (size_t)(row0 + tr) * 16);
        const float ss = sum4(sp[0]) + sum4(sp[1]) + sum4(sp[2]) + sum4(sp[3]);
        const float rsv = rsqrtf(ss * (1.0f / 1024.f) + EPS);
#pragma unroll
        for (int i = 0; i < 4; ++i) {
            const int c8 = tc + 4 * i;
            const u32x4 zv = *(const u32x4*)(Z + (size_t)(row0 + tr) * INC + 5 * 1024 + g * 128 + c8 * 8);
            const f32x4 nw0 = *(const f32x4*)(normw + g * 128 + c8 * 8), nw1 = *(const f32x4*)(normw + g * 128 + c8 * 8 + 4);
#pragma unroll
            for (int e = 0; e < 8; e += 2) {
                const unsigned wv = zv[e >> 1]; const float s0 = (e < 4 ? nw0[e & 3] : nw1[e & 3]) * rsv, s1 = (e < 4 ? nw0[(e + 1) & 3] : nw1[(e + 1) & 3]) * rsv;
                const unsigned pk = cvt_pk_bf16(bf_lo(wv) * s0, bf_hi(wv) * s1);
                vt[(c8 * 8 + e) * TP + tr] = (unsigned short)(pk & 0xffffu); vt[(c8 * 8 + e + 1) * TP + tr] = (unsigned short)(pk >> 16);
            }
        }
    }
    LBAR();
    const int n = 16 * w + fr, row = row0 + n;
    bf16x8 wf[4];
#pragma unroll
    for (int ks = 0; ks < 4; ++ks) wf[ks] = *(const LAS bf16x8*)(Wsl + n * TP + ks * 32 + fq * 8);
    const float bn = sgub[g * 128 + n];
#pragma unroll
    for (int db = 0; db < 8; ++db) {
        f32x4 s = {0.f, 0.f, 0.f, 0.f};
#pragma unroll
        for (int ks = 0; ks < 4; ++ks) { const bf16x8 vf = *(const LAS bf16x8*)(vt + (16 * db + fr) * TP + ks * 32 + fq * 8); s = MFMA16(vf, wf[ks], s); }
        const int col = g * 128 + 16 * db + 4 * fq;
        const u32x2 uu = *(const u32x2*)(Z + (size_t)row * INC + 4 * 1024 + col);
        f32x4 o; o[0] = bf_lo(uu.x) * (s[0] + bn); o[1] = bf_hi(uu.x) * (s[1] + bn); o[2] = bf_lo(uu.y) * (s[2] + bn); o[3] = bf_hi(uu.y) * (s[3] + bn);
        *(u32x2*)(MIX + (size_t)row * DM + 1024 + col) = pack4(o);
    }
    LBAR();
}

DI void inner_item(LAS unsigned char* lds, int item, const bf16_t* Z, const float* crossF, const float* crossB, const float* gnw, const float* lgf, const float* lgb, bf16_t* MIX) {
    const int tid = threadIdx.x, lane = tid & 63, w = tid >> 6, fr = lane & 15, fq = lane >> 4;
    const int chunk = item >> 3, h = item & 7, row0 = chunk * 128;
    LAS bf16_t* Qs = (LAS bf16_t*)lds; LAS bf16_t* Ks = Qs + 128 * TP; LAS bf16_t* Vt = Ks + 128 * TP;
    const bf16_t* zb = Z + (size_t)row0 * INC + h * 128;
    const int tr = tid & 127, tc = tid >> 7;
#pragma unroll
    for (int i = 0; i < 4; ++i) {
        const int v = tid + 512 * i;
        const u32x4 q = *(const u32x4*)(zb + (size_t)(v >> 4) * INC + (v & 15) * 8), k = *(const u32x4*)(zb + (size_t)(v >> 4) * INC + 1024 + (v & 15) * 8);
        const u32x4 vv = *(const u32x4*)(zb + (size_t)tr * INC + 2048 + (tc + 4 * i) * 8);
        *(LAS u32x4*)(Qs + (v >> 4) * TP + (v & 15) * 8) = q; *(LAS u32x4*)(Ks + (v >> 4) * TP + (v & 15) * 8) = k;
#pragma unroll
        for (int e = 0; e < 8; ++e) Vt[((tc + 4 * i) * 8 + e) * TP + tr] = u16_of(vv, e);
    }
    LBAR();
    const float l2f = lgf[h] * LOG2E, l2b = lgb[h] * LOG2E;
    const int n = 16 * w + fr, row = row0 + n;
    bf16x8 qf[4];
#pragma unroll
    for (int ks = 0; ks < 4; ++ks) qf[ks] = *(const LAS bf16x8*)(Qs + n * TP + ks * 32 + fq * 8);
    asm volatile("s_waitcnt lgkmcnt(0)" ::: "memory");
#pragma unroll
    for (int mb = 0; mb < 8; ++mb) {
        f32x4 s = {0.f, 0.f, 0.f, 0.f};
#pragma unroll
        for (int ks = 0; ks < 4; ++ks) { const bf16x8 kf = *(const LAS bf16x8*)(Ks + (16 * mb + fr) * TP + ks * 32 + fq * 8); s = MFMA16(kf, qf[ks], s); }
#pragma unroll
        for (int r = 0; r < 4; ++r) { const int d = n - (16 * mb + 4 * fq + r); s[r] *= d >= 0 ? exp2f(l2f * (float)d) : exp2f(l2b * (float)(-d)); }
        *(LAS u32x2*)(Qs + n * TP + 16 * mb + 4 * fq) = pack4(s);
    }
    asm volatile("s_waitcnt lgkmcnt(0)" ::: "memory");
    bf16x8 wf[4];
#pragma unroll
    for (int ks = 0; ks < 4; ++ks) wf[ks] = *(const LAS bf16x8*)(Qs + n * TP + ks * 32 + fq * 8);
    f32x4 o[8]; float sm = 0.f;
#pragma unroll
    for (int eb = 0; eb < 8; ++eb) {
        f32x4 a = {0.f, 0.f, 0.f, 0.f};
#pragma unroll
        for (int ks = 0; ks < 4; ++ks) { const bf16x8 vf = *(const LAS bf16x8*)(Vt + (16 * eb + fr) * TP + ks * 32 + fq * 8); a = MFMA16(vf, wf[ks], a); }
        const int col = h * 128 + 16 * eb + 4 * fq;
        a = a + *(const f32x4*)(crossF + (size_t)row * RW + col) + *(const f32x4*)(crossB + (size_t)row * RW + col);
        o[eb] = a; sm += sum4(a);
    }
    sm += __shfl_xor(sm, 16); sm += __shfl_xor(sm, 32);
    const float mean = sm * (1.0f / 128.f); float vs = 0.f;
#pragma unroll
    for (int eb = 0; eb < 8; ++eb) { o[eb] = o[eb] - mean; vs += sq4(o[eb]); }
    vs += __shfl_xor(vs, 16); vs += __shfl_xor(vs, 32);
    const float rstd = rsqrtf(vs * (1.0f / 128.f) + EPS);
#pragma unroll
    for (int eb = 0; eb < 8; ++eb) {
        const int col = h * 128 + 16 * eb + 4 * fq;
        const u32x2 gg = *(const u32x2*)(Z + (size_t)row * INC + 3 * 1024 + col);
        const f32x4 gw = *(const f32x4*)(gnw + col);
        f32x4 r; r[0] = bf_lo(gg.x) * (o[eb][0] * rstd * gw[0]); r[1] = bf_hi(gg.x) * (o[eb][1] * rstd * gw[1]); r[2] = bf_lo(gg.y) * (o[eb][2] * rstd * gw[2]); r[3] = bf_hi(gg.y) * (o[eb][3] * rstd * gw[3]);
        *(u32x2*)(MIX + (size_t)row * DM + col) = pack4(r);
    }
    LBAR();
}

struct Args { const float* in[17]; float* out; unsigned char* ws; };

__global__ void __launch_bounds__(512, 2) fwd_kernel(Args a) {
    extern __shared__ __attribute__((aligned(16))) unsigned char lds_raw[];
    LAS unsigned char* lds = (LAS unsigned char*)lds_raw;
    cg::grid_group grid = cg::this_grid();
    const int tid = threadIdx.x, lane = tid & 63, wave = __builtin_amdgcn_readfirstlane(tid >> 6);
    const int G = gridDim.x, bid = blockIdx.x;
    unsigned char* ws = a.ws;
    const float* xp = a.in[0]; const float* xs = a.in[1];
    bf16_t* Win_t = (bf16_t*)(ws + WS_WIN); bf16_t* Wout_t = (bf16_t*)(ws + WS_WOUT); bf16_t* Wup_t = (bf16_t*)(ws + WS_WUP); bf16_t* Wdown_t = (bf16_t*)(ws + WS_WDOWN);
    bf16_t* Zb = (bf16_t*)(ws + WS_Z); bf16_t* X1B = (bf16_t*)(ws + WS_X1B); bf16_t* ACT = (bf16_t*)(ws + WS_ACT); bf16_t* MIX = (bf16_t*)(ws + WS_MIX);
    float* HALO = (float*)(ws + WS_HALO); float* ROPE = (float*)(ws + WS_ROPE); float* RS1 = (float*)(ws + WS_RS1);
    float* SSQV = (float*)(ws + WS_SSQV); float* SSQ2 = (float*)(ws + WS_SSQ2); float* SSQ3 = (float*)(ws + WS_SSQ3);
    unsigned* CTL = (unsigned*)(ws + WS_CTL);
    bf16_t* XB = (bf16_t*)a.out; float* crossF = a.out; float* crossB = a.out + (size_t)T * RW; float* X1 = a.out;

    if (PH_MASK & 1) {
        LAS float* scr = (LAS float*)(lds + wave * 16384);
        const int gw = bid * 8 + wave, NGW = G * 8;
        constexpr int I_IN = (DM / 64) * (INC / 32), I_OUT = (DM / 64) * (DM / 32), I_UP = (DM / 64) * (FF2 / 32), I_DN = (FF / 64) * (DM / 32);
        for (int it = gw; it < I_IN + I_OUT + I_UP + I_DN; it += NGW) {
            int r = it;
            if (r < I_IN) { p0_transpose_item(a.in[3], DM, INC, Win_t, a.in[2], 1, scr, r, lane); continue; } r -= I_IN;
            if (r < I_OUT) { p0_transpose_item(a.in[10], DM, DM, Wout_t, nullptr, 0, scr, r, lane); continue; } r -= I_OUT;
            if (r < I_UP) { p0_transpose_item(a.in[12], DM, FF2, Wup_t, a.in[11], 2, scr, r, lane); continue; } r -= I_UP;
            p0_transpose_item(a.in[15], FF, DM, Wdown_t, nullptr, 0, scr, r, lane);
        }
        for (int row = gw; row < T; row += NGW) {
            const float* xr = row < 8192 ? xp + (size_t)row * DM : xs + (size_t)(row - 8192) * DM;
            f32x4 v[8]; float s = 0.f;
#pragma unroll
            for (int j = 0; j < 8; ++j) { v[j] = *(const f32x4*)(xr + 256 * j + 4 * lane); s += sq4(v[j]); }
            s = wave_sum(s);
            if (lane == 0) RS1[row] = rsqrtf(s * (1.0f / DM) + EPS);
#pragma unroll
            for (int j = 0; j < 8; ++j) *(u32x2*)(XB + (size_t)row * DM + 256 * j + 4 * lane) = pack4(v[j]);
        }
        for (int e = bid * 512 + tid; e < 8192 * 64; e += G * 512) {
            const int pos = e >> 6, j = e & 63;
            const float inv = (float)exp2(-(double)j * (13.287712379549449 / 64.0));
            const float ang = (float)pos * inv;
            double rev = (double)ang * 0.15915494309189535; rev -= floor(rev);
            const float fr_ = (float)rev;
            ROPE[2 * e] = __builtin_amdgcn_cosf(fr_); ROPE[2 * e + 1] = __builtin_amdgcn_sinf(fr_);
        }
    }
    grid.sync();

    if (PH_MASK & 2) {
        pg8::Gemm g{XB, Win_t, T, INC, DM}; pg8::StaticOrder S; S.init(T, INC, G, bid);
        EpiIn E{Zb, RS1, ROPE, SSQV};
        pg8::gemm_phase<EpiIn, pg8::StaticOrder, true, true>(lds, g, S, E);
    }
    grid.sync();

    if (PH_MASK & 4) {
        volatile LAS int* sh = (volatile LAS int*)(lds + MISC_OFF);
        for (;;) {
            if (tid == 0) sh[0] = (int)atomicAdd(CTL, 1u);
            __syncthreads();
            const int item = sh[0];
            __syncthreads();
            if (item >= 192 + 1024) break;
            if (item < 192) scan_item(lds, item, Zb, crossF, crossB, a.in[4], a.in[5]);
            else sgu_item(lds, item - 192, Zb, SSQV, a.in[7], a.in[8], a.in[9], MIX);
        }
    }
    grid.sync();

    if (PH_MASK & 8) for (int item = bid; item < 1024; item += G) inner_item(lds, item, Zb, crossF, crossB, a.in[6], a.in[4], a.in[5], MIX);
    grid.sync();

    if (PH_MASK & 16) {
        pg8::Gemm g{MIX, Wout_t, T, DM, DM}; pg8::StaticOrder S; S.init(T, DM, G, bid);
        EpiRes<false> E{xp, xs, X1, X1B, SSQ2};
        pg8::gemm_phase<EpiRes<false>, pg8::StaticOrder, true, true>(lds, g, S, E);
    }
    grid.sync();

    if (PH_MASK & 32) {
        pg8::Gemm g{X1B, Wup_t, T, FF2, DM}; pg8::StaticOrder S; S.init(T, FF2, G, bid);
        EpiUp E{ACT, HALO, SSQ2, a.in[13], a.in[14], (LAS float*)(lds + EX_OFF)};
        pg8::gemm_phase<EpiUp, pg8::StaticOrder, true, true>(lds, g, S, E);
    }
    grid.sync();

    if (PH_MASK & 64) {
        const float* cw = a.in[13]; const float* cb = a.in[14];
        for (int e = bid * 512 + tid; e < 128 * FF; e += G * 512) {
            const int idx = e / FF, c = e - idx * FF, p = idx >> 1, which = idx & 1;
            const int row = p * 256 + (which ? 255 : 0);
            const bool first = (row == 0) || (row == 4096) || (row == 8192), last = (row == 4095) || (row == 8191) || (row == 16383);
            const int pa = 256 * (c >> 7) + (c & 127), pb = pa + 128;
            const float* hp = HALO + (size_t)(p * 4) * FF2;
            float pra, prb, cua, cub, nxa, nxb;
            if (which == 0) {
                pra = first ? 0.f : hp[-(ptrdiff_t)FF2 + pa]; prb = first ? 0.f : hp[-(ptrdiff_t)FF2 + pb];
                cua = hp[pa]; cub = hp[pb]; nxa = hp[FF2 + pa]; nxb = hp[FF2 + pb];
            } else {
                pra = hp[2 * FF2 + pa]; prb = hp[2 * FF2 + pb]; cua = hp[3 * FF2 + pa]; cub = hp[3 * FF2 + pb];
                nxa = last ? 0.f : hp[4 * (size_t)FF2 + pa]; nxb = last ? 0.f : hp[4 * (size_t)FF2 + pb];
            }
            const float va = cw[c] * pra + cw[FF2 + c] * cua + cw[2 * FF2 + c] * nxa + cb[c];
            const float vb = cw[FF + c] * prb + cw[FF2 + FF + c] * cub + cw[2 * FF2 + FF + c] * nxb + cb[FF + c];
            ACT[(size_t)row * FF + c] = (bf16_t)(cvt_pk_bf16(silu_f(va) * vb, 0.f) & 0xffffu);
        }
    }
    grid.sync();

    if (PH_MASK & 128) {
        pg8::Gemm g{ACT, Wdown_t, T, DM, FF}; pg8::StaticOrder S; S.init(T, DM, G, bid);
        EpiRes<true> E{nullptr, nullptr, X1, nullptr, SSQ3};
        pg8::gemm_phase<EpiRes<true>, pg8::StaticOrder, true, true>(lds, g, S, E);
    }
    grid.sync();

    if (PH_MASK & 256) {
        const int gw = bid * 8 + wave, NGW = G * 8; const float* fw = a.in[16];
        for (int row = gw; row < T; row += NGW) {
            float s = lane < 32 ? SSQ3[(size_t)row * 32 + lane] : 0.f;
            s = wave_sum(s);
            const float rs = rsqrtf(s * (1.0f / DM) + EPS);
            float* orow = a.out + (size_t)row * DM;
#pragma unroll
            for (int j = 0; j < 8; ++j) { const f32x4 v = *(const f32x4*)(orow + 256 * j + 4 * lane), wv = *(const f32x4*)(fw + 256 * j + 4 * lane); *(f32x4*)(orow + 256 * j + 4 * lane) = v * rs * wv; }
        }
    }
}

extern "C" void kernel_launch(void* const* d_in, const int* in_sizes, int n_in, void* d_out, int out_size, void* d_ws, size_t ws_size, hipStream_t stream) {
    static int grid = 0;
    if (grid == 0) {
        if (n_in != 17 || out_size != 2 * T / 2 * DM || ws_size < WS_END) { fprintf(stderr, "kernel_launch: unexpected sizes n_in %d out %d ws %zu (need %zu)\n", n_in, out_size, ws_size, (size_t)WS_END); grid = -1; }
        else {
            int dev = 0, cus = 0, per_cu = 0;
            (void)hipGetDevice(&dev); (void)hipDeviceGetAttribute(&cus, hipDeviceAttributeMultiprocessorCount, dev);
            (void)hipFuncSetAttribute((const void*)fwd_kernel, hipFuncAttributeMaxDynamicSharedMemorySize, LDS_BYTES);
            (void)hipOccupancyMaxActiveBlocksPerMultiprocessor(&per_cu, (const void*)fwd_kernel, 512, LDS_BYTES);
            if (per_cu < 1 || cus < 1) { fprintf(stderr, "kernel_launch: occupancy query says %d blocks/CU on %d CUs\n", per_cu, cus); grid = -1; }
            else grid = cus;
        }
    }
    if (grid < 0) { (void)hipMemsetAsync(d_out, 0, (size_t)out_size * 4, stream); return; }
    (void)hipMemsetAsync((char*)d_ws + WS_CTL, 0, 4096, stream);
    Args a{};
    for (int i = 0; i < 17; ++i) a.in[i] = (const float*)d_in[i];
    a.out = (float*)d_out; a.ws = (unsigned char*)d_ws;
    void* kargs[] = {&a};
    const hipError_t e = hipLaunchCooperativeKernel((const void*)fwd_kernel, dim3(grid), dim3(512), kargs, LDS_BYTES, stream);
    if (e != hipSuccess) fprintf(stderr, "kernel_launch: cooperative launch failed: %s (grid %d)\n", hipGetErrorString(e), grid);
}
```

```cpp
#include <hip/hip_runtime.h>
#include <hip/hip_cooperative_groups.h>
#include <cstdio>
#include <cstdint>
namespace cg = cooperative_groups;
namespace pg8 {
#define PG8_LAS __attribute__((address_space(3)))
typedef unsigned short bf16_t;
typedef short bf16x8 __attribute__((ext_vector_type(8)));
typedef float f32x4 __attribute__((ext_vector_type(4)));
typedef unsigned u32x4 __attribute__((ext_vector_type(4)));
constexpr int BM = 256, BK = 64, HALF = 128, HTB = HALF * BK * 2  , STAGE_BYTES = 8 * HTB, NXCD = 8, WGM = 8;

__host__ __device__ __forceinline__ int lds_byte(int r, int c) { const int st = (r >> 4) * 2 + (c >> 5), rr = r & 15, cc = c & 31, ob = rr * 64 + cc * 2; return st * 1024 + (ob ^ (((ob >> 9) & 1) << 5)); }
__host__ __device__ __forceinline__ void stage_rc(int b, int& R, int& C) { const int st = b / 1024, sb = b % 1024, swz = sb ^ (((sb >> 9) & 1) << 5); R = (st >> 1) * 16 + swz / 64; C = (st & 1) * 32 + (swz % 64) / 2; }
__host__ __device__ __forceinline__ int perm32(int rho) { const int n = rho >> 4, i = rho & 15; return 8 * (i >> 2) + 4 * n + (i & 3); }

struct Unit { int pm, pn; };
struct Gemm { const bf16_t* A; const bf16_t* Bt; int M, N, K; };

struct StaticOrder {
    int nM, nN, nwg, G, c;
    __host__ __device__ void init(int M, int N, int G_, int c_) { nM = M / BM; nN = N / BM; nwg = nM * nN; G = G_; c = c_; }
    __host__ __device__ bool next(int i, Unit& u) const {
        const long L = (long)i * G + c; if (L >= nwg) return false;
        int wgid = (int)L; { const int q = nwg / NXCD, r = nwg % NXCD, xcd = wgid % NXCD, off = wgid / NXCD; wgid = (xcd < r ? xcd * (q + 1) : r * (q + 1) + (xcd - r) * q) + off; }
        const int nig = WGM * nN, gid = wgid / nig, fm = gid * WGM, gsz = (nM - fm) < WGM ? (nM - fm) : WGM;
        u.pm = fm + ((wgid % nig) % gsz); u.pn = (wgid % nig) / gsz; return true;
    }
    __device__ __forceinline__ void a_ready(const Unit&) const {}
    __device__ __forceinline__ void done(const Unit&) const {}
};

__device__ __forceinline__ unsigned cvt_pk_bf16(float lo, float hi) { unsigned r; asm volatile("v_cvt_pk_bf16_f32 %0, %1, %2" : "=v"(r) : "v"(lo), "v"(hi)); return r; }
template <class Epi, class Sched, bool ALIGN_EPI = false, bool SP2 = false>
__device__ __forceinline__ void gemm_phase(PG8_LAS unsigned char* lds, const Gemm g, const Sched& S, const Epi& E) {
    int tid_ = threadIdx.x; asm volatile("" : "+v"(tid_));
    const int tid = tid_, wid = __builtin_amdgcn_readfirstlane(tid >> 6), lane = tid & 63, wr = wid >> 2, wc = wid & 3, fr = lane & 15, fq = lane >> 4;
    const int K = g.K, nt = K / BK;
    unsigned voffA[2], voffB[2];
#pragma unroll
    for (int i = 0; i < 2; ++i) { int R, C; stage_rc(tid * 16 + i * 8192, R, C); const int Rb = Epi::PERM ? ((R & ~31) + perm32(R & 31)) : R;
        const int Ra = Epi::PERMA ? ((R & 64) + 4 * (R & 15) + ((R >> 4) & 3)) : R; voffA[i] = (unsigned)(Ra * K + C) * 2u; voffB[i] = (unsigned)(Rb * K + C) * 2u; }
    const size_t kstep = (size_t)(BK * 2);
    const size_t hstep = (size_t)HALF * K * 2;
    const size_t tstep = 2 * hstep;
    const unsigned ldsw = (unsigned)wid * 1024u;
    const int aoff = lds_byte(wr * 64 + fr, fq * 8), boff = lds_byte(wc * 32 + fr, fq * 8);
#define PG8_SA(b, h) (((b) * 2 + (h)) * HTB)
#define PG8_SB(b, h) ((4 + (b) * 2 + (h)) * HTB)
#define PG8_STAGE(bufoff, gbase, voff) do { _Pragma("unroll") for (int _i = 0; _i < 2; ++_i) \
        __builtin_amdgcn_global_load_lds((const unsigned*)((const char*)(gbase) + (voff)[_i]), (PG8_LAS unsigned*)(lds + (bufoff) + ldsw + _i * 8192), 16, 0, 0); } while (0)
#define PG8_LDA(dst, b, h) do { _Pragma("unroll") for (int m = 0; m < 4; ++m) _Pragma("unroll") for (int k = 0; k < 2; ++k) dst[m][k] = *(const PG8_LAS bf16x8*)(lds + PG8_SA(b, h) + aoff + m * 2048 + k * 1024); } while (0)
#define PG8_LDB(dst, b, h) do { _Pragma("unroll") for (int n = 0; n < 2; ++n) _Pragma("unroll") for (int k = 0; k < 2; ++k) dst[n][k] = *(const PG8_LAS bf16x8*)(lds + PG8_SB(b, h) + boff + n * 2048 + k * 1024); } while (0)
#define PG8_MMA(ai, bj, At, Bt) do { __builtin_amdgcn_s_setprio(1); _Pragma("unroll") for (int m = 0; m < 4; ++m) _Pragma("unroll") for (int n = 0; n < 2; ++n) _Pragma("unroll") for (int k = 0; k < 2; ++k) \
        acc[ai][bj][m][n] = __builtin_amdgcn_mfma_f32_16x16x32_bf16(Bt[n][k], At[m][k], acc[ai][bj][m][n], 0, 0, 0); __builtin_amdgcn_s_setprio(0); } while (0)
#define PG8_WAIT_V(n) asm volatile("s_waitcnt vmcnt(" #n ")" ::: "memory")
#define PG8_WAIT_L(n) asm volatile("s_waitcnt lgkmcnt(" #n ")" ::: "memory")
#define PG8_BAR __builtin_amdgcn_s_barrier()
#define PG8_SCHED __builtin_amdgcn_sched_barrier(0)
    Unit cur, nxt; int ui = 0;
    if (!S.next(0, cur)) return;
    f32x4 acc[2][2][4][2];
#pragma unroll
    for (int a = 0; a < 2; ++a)
#pragma unroll
        for (int b = 0; b < 2; ++b)
#pragma unroll
            for (int m = 0; m < 4; ++m)
#pragma unroll
                for (int n = 0; n < 2; ++n) acc[a][b][m][n] = (f32x4){0.f, 0.f, 0.f, 0.f};
    bf16x8 At[4][2], B0[2][2], B1[2][2];
    const char* cA = (const char*)g.A + (size_t)cur.pm * tstep; const char* cB = (const char*)g.Bt + (size_t)cur.pn * tstep;
    S.a_ready(cur);
    if constexpr (SP2) {
        PG8_STAGE(PG8_SB(0, 0), cB, voffB); PG8_STAGE(PG8_SB(0, 1), cB + hstep, voffB); PG8_STAGE(PG8_SA(0, 0), cA, voffA); PG8_STAGE(PG8_SA(0, 1), cA + hstep, voffA);
        if (wr == 1) PG8_BAR;
        PG8_WAIT_V(2); PG8_BAR;
        PG8_STAGE(PG8_SB(1, 0), cB + kstep, voffB); PG8_STAGE(PG8_SA(1, 0), cA + kstep, voffA); PG8_STAGE(PG8_SB(1, 1), cB + hstep + kstep, voffB);
        PG8_WAIT_V(6); PG8_BAR;
    } else {
        PG8_STAGE(PG8_SB(0, 0), cB, voffB); PG8_STAGE(PG8_SA(0, 0), cA, voffA); PG8_STAGE(PG8_SB(0, 1), cB + hstep, voffB); PG8_STAGE(PG8_SA(0, 1), cA + hstep, voffA);
        if (wr == 1) PG8_BAR;
        PG8_WAIT_V(4); PG8_BAR;
        PG8_STAGE(PG8_SB(1, 0), cB + kstep, voffB); PG8_STAGE(PG8_SA(1, 0), cA + kstep, voffA); PG8_STAGE(PG8_SB(1, 1), cB + hstep + kstep, voffB);
        PG8_WAIT_V(6); PG8_BAR;
    }
    for (;;) {
        const bool has_next = S.next(ui + 1, nxt);
        const char* nA = has_next ? (const char*)g.A + (size_t)nxt.pm * tstep : cA; const char* nB = has_next ? (const char*)g.Bt + (size_t)nxt.pn * tstep : cB;
        for (int t = 0; t < nt; t += 2) {
            const bool last = (t == nt - 2);
            const char* a1 = cA + (size_t)(t + 1) * kstep;
            const char* a2 = last ? nA : cA + (size_t)(t + 2) * kstep; const char* b2 = last ? nB : cB + (size_t)(t + 2) * kstep;
            const char* a3 = a2 + kstep; const char* b3 = b2 + kstep;
            if (last && has_next) S.a_ready(nxt);
            if constexpr (SP2) {
            PG8_LDB(B0, 0, 0); PG8_LDB(B1, 0, 1); PG8_SCHED; PG8_LDA(At, 0, 0); PG8_STAGE(PG8_SA(1, 1), a1 + hstep, voffA);
            PG8_WAIT_V(8); PG8_WAIT_L(0); PG8_BAR; PG8_MMA(0, 0, At, B0); PG8_MMA(0, 1, At, B1); PG8_BAR; PG8_SCHED;
            PG8_LDA(At, 0, 1); PG8_STAGE(PG8_SB(0, 0), b2, voffB); PG8_STAGE(PG8_SB(0, 1), b2 + hstep, voffB); PG8_STAGE(PG8_SA(0, 0), a2, voffA);
            PG8_WAIT_V(8); PG8_WAIT_L(0); PG8_BAR; PG8_MMA(1, 0, At, B0); PG8_MMA(1, 1, At, B1); PG8_BAR; PG8_SCHED;
            PG8_LDB(B0, 1, 0); PG8_LDB(B1, 1, 1); PG8_SCHED; PG8_LDA(At, 1, 0); PG8_STAGE(PG8_SA(0, 1), a2 + hstep, voffA);
            PG8_WAIT_V(8); PG8_WAIT_L(0); PG8_BAR; PG8_MMA(0, 0, At, B0); PG8_MMA(0, 1, At, B1); PG8_BAR; PG8_SCHED;
            PG8_LDA(At, 1, 1); PG8_STAGE(PG8_SB(1, 0), b3, voffB); PG8_STAGE(PG8_SB(1, 1), b3 + hstep, voffB); PG8_STAGE(PG8_SA(1, 0), a3, voffA);
            PG8_WAIT_V(8); PG8_WAIT_L(0); PG8_BAR; PG8_MMA(1, 0, At, B0); PG8_MMA(1, 1, At, B1); PG8_BAR; PG8_SCHED;
            } else {
            PG8_LDB(B0, 0, 0); PG8_SCHED; PG8_LDA(At, 0, 0); PG8_STAGE(PG8_SA(1, 1), a1 + hstep, voffA);
            PG8_WAIT_L(8); PG8_BAR; PG8_WAIT_L(0); PG8_MMA(0, 0, At, B0); PG8_BAR; PG8_SCHED;
            PG8_LDB(B1, 0, 1); PG8_STAGE(PG8_SB(0, 0), b2, voffB);
            PG8_BAR; PG8_WAIT_L(0); PG8_MMA(0, 1, At, B1); PG8_BAR;
            PG8_LDA(At, 0, 1); PG8_STAGE(PG8_SA(0, 0), a2, voffA);
            PG8_BAR; PG8_WAIT_L(0); PG8_MMA(1, 0, At, B0); PG8_BAR; PG8_SCHED;
            PG8_STAGE(PG8_SB(0, 1), b2 + hstep, voffB);
            PG8_WAIT_V(6); PG8_BAR; PG8_MMA(1, 1, At, B1); PG8_BAR;
            PG8_LDB(B0, 1, 0); PG8_SCHED; PG8_LDA(At, 1, 0); PG8_STAGE(PG8_SA(0, 1), a2 + hstep, voffA);
            PG8_WAIT_L(8); PG8_BAR; PG8_WAIT_L(0); PG8_MMA(0, 0, At, B0); PG8_BAR; PG8_SCHED;
            PG8_LDB(B1, 1, 1); PG8_STAGE(PG8_SB(1, 0), b3, voffB);
            PG8_BAR; PG8_WAIT_L(0); PG8_MMA(0, 1, At, B1); PG8_BAR;
            PG8_LDA(At, 1, 1); PG8_STAGE(PG8_SA(1, 0), a3, voffA);
            PG8_BAR; PG8_WAIT_L(0); PG8_MMA(1, 0, At, B0); PG8_BAR; PG8_SCHED;
            PG8_STAGE(PG8_SB(1, 1), b3 + hstep, voffB);
            PG8_WAIT_V(6); PG8_BAR; PG8_MMA(1, 1, At, B1); PG8_BAR;
            }
        }
        if constexpr (ALIGN_EPI) { if (wr == 0) PG8_BAR; }
        if constexpr (!Epi::AFTER_DRAIN) { E(acc, cur, wr, wc, fr, fq); S.done(cur); }
        if (!has_next) break;
#pragma unroll
        for (int a = 0; a < 2; ++a)
#pragma unroll
            for (int b = 0; b < 2; ++b)
#pragma unroll
                for (int m = 0; m < 4; ++m)
#pragma unroll
                    for (int n = 0; n < 2; ++n) acc[a][b][m][n] = (f32x4){0.f, 0.f, 0.f, 0.f};
        cur = nxt; cA = nA; cB = nB; ++ui;
        if constexpr (ALIGN_EPI) { if (wr == 1) PG8_BAR; }
    }
    PG8_WAIT_V(0);
    if constexpr (!ALIGN_EPI) { if (wr == 0) PG8_BAR; }
    PG8_BAR;
    if constexpr (Epi::AFTER_DRAIN) { E.fused(acc, cur, wr, wc, fr, fq, lds, wid, lane); S.done(cur); }
#undef PG8_SA
#undef PG8_SB
#undef PG8_STAGE
#undef PG8_LDA
#undef PG8_LDB
#undef PG8_MMA
#undef PG8_WAIT_V
#undef PG8_WAIT_L
#undef PG8_BAR
#undef PG8_SCHED
}
}

#ifndef PH_MASK
#define PH_MASK 0x1ff
#endif
#ifndef REP_MASK
#define REP_MASK 0
#endif
#define DI __device__ __forceinline__
#define LAS __attribute__((address_space(3)))
using pg8::bf16_t; using pg8::bf16x8; using pg8::f32x4; using pg8::u32x4; using pg8::cvt_pk_bf16;
typedef unsigned u32x2 __attribute__((ext_vector_type(2)));

constexpr int T = 16384, DM = 2048, INC = 6144, FF = 5632, FF2 = 11264, RW = 1024;
constexpr float EPS = 1e-6f, LOG2E = 1.4426950408889634f;
constexpr size_t MiB = 1u << 20;
constexpr size_t WS_CTL = 0, WS_ROPE = 1 * MiB, WS_WOUT = 5 * MiB, WS_WUP = 13 * MiB, WS_WDOWN = 57 * MiB;
constexpr size_t WS_Z = 79 * MiB;
constexpr size_t WS_X1B = 79 * MiB;
constexpr size_t WS_ACT = 143 * MiB;
constexpr size_t WS_WIN = 271 * MiB;
constexpr size_t WS_MIX = 271 * MiB;
constexpr size_t WS_HALO = 319 * MiB;
constexpr size_t WS_RS1 = 336 * MiB, WS_SSQV = 337 * MiB, WS_SSQ2 = 338 * MiB, WS_SSQ3 = 340 * MiB, WS_END = 342 * MiB;
constexpr int RING_BYTES = 131072, EX_OFF = 131072, MISC_OFF = 139264, LDS_BYTES = 147456;
constexpr int TP = 136;
constexpr int TR_OUT = (DM / 128) * (DM / 512), TR_UP = (DM / 128) * (FF2 / 512), TR_DN = (FF / 128) * (DM / 512), TR_ITEMS = TR_OUT + TR_UP + TR_DN;

DI float silu_f(float x) { return x * __builtin_amdgcn_rcpf(1.f + __builtin_amdgcn_exp2f(-LOG2E * x)); }
DI float gelu_f(float x) { const float u = x + 0.044715f * x * x * x; return x * __builtin_amdgcn_rcpf(1.f + __builtin_amdgcn_exp2f(-2.f * 0.7978845608028654f * LOG2E * u)); }
DI f32x4 silu4(f32x4 x) { const f32x4 t = x * (-LOG2E); f32x4 e; e[0] = __builtin_amdgcn_exp2f(t[0]); e[1] = __builtin_amdgcn_exp2f(t[1]); e[2] = __builtin_amdgcn_exp2f(t[2]); e[3] = __builtin_amdgcn_exp2f(t[3]);
    const f32x4 d = e + 1.0f; f32x4 r; r[0] = __builtin_amdgcn_rcpf(d[0]); r[1] = __builtin_amdgcn_rcpf(d[1]); r[2] = __builtin_amdgcn_rcpf(d[2]); r[3] = __builtin_amdgcn_rcpf(d[3]); return x * r; }
DI f32x4 gelu4(f32x4 x) { const f32x4 u = x * (x * x * 0.044715f + 1.0f); const f32x4 t = u * (-2.f * 0.7978845608028654f * LOG2E);
    f32x4 e; e[0] = __builtin_amdgcn_exp2f(t[0]); e[1] = __builtin_amdgcn_exp2f(t[1]); e[2] = __builtin_amdgcn_exp2f(t[2]); e[3] = __builtin_amdgcn_exp2f(t[3]);
    const f32x4 d = e + 1.0f; f32x4 r; r[0] = __builtin_amdgcn_rcpf(d[0]); r[1] = __builtin_amdgcn_rcpf(d[1]); r[2] = __builtin_amdgcn_rcpf(d[2]); r[3] = __builtin_amdgcn_rcpf(d[3]); return x * r; }
DI float bf_lo(unsigned w) { return __uint_as_float(w << 16); }
DI float bf_hi(unsigned w) { return __uint_as_float(w & 0xffff0000u); }
DI unsigned short u16_of(const u32x4& v, int e) { const unsigned w = v[e >> 1]; return (unsigned short)((e & 1) ? (w >> 16) : (w & 0xffffu)); }
DI u32x2 pack4(const f32x4& v) { u32x2 r; r.x = cvt_pk_bf16(v[0], v[1]); r.y = cvt_pk_bf16(v[2], v[3]); return r; }
DI float sum4(const f32x4& v) { return (v[0] + v[1]) + (v[2] + v[3]); }
DI float sq4(const f32x4& v) { return (v[0] * v[0] + v[1] * v[1]) + (v[2] * v[2] + v[3] * v[3]); }
DI float wave_sum(float v) {
#pragma unroll
    for (int o = 1; o < 64; o <<= 1) v += __shfl_xor(v, o);
    return v;
}
#define LBAR() do { asm volatile("s_waitcnt lgkmcnt(0)" ::: "memory"); __builtin_amdgcn_s_barrier(); asm volatile("" ::: "memory"); } while (0)
#define MFMA16(a, b, c) __builtin_amdgcn_mfma_f32_16x16x32_bf16((a), (b), (c), 0, 0, 0)

struct EpiIn {
    static constexpr bool PERM = true, AFTER_DRAIN = false, PERMA = false;
    bf16_t* Z; const float* rs1; const float* rope; float* ssqv;
    DI void operator()(const f32x4 (&acc)[2][2][4][2], const pg8::Unit& u, int wr, int wc, int fr, int fq) const {
        const int region = u.pn >> 2;
#pragma unroll
        for (int ai = 0; ai < 2; ++ai)
#pragma unroll
            for (int m = 0; m < 4; ++m) {
                const int row = u.pm * 256 + ai * 128 + wr * 64 + m * 16 + fr;
                const float rs = rs1[row];
                bf16_t* zr = Z + (size_t)row * INC;
                if (region < 2) {
                    const int pos = row < 4096 ? row : (row < 8192 ? row - 4096 : row - 8192);
                    const f32x4* rp = (const f32x4*)(rope + ((size_t)pos * 64 + 16 * wc + 4 * fq) * 2);
                    const f32x4 cs0 = rp[0], cs1 = rp[1];
#pragma unroll
                    for (int bj = 0; bj < 2; ++bj) {
                        const f32x4 x1 = acc[ai][bj][m][0] * rs, x2 = acc[ai][bj][m][1] * rs;
                        f32x4 o1, o2;
                        o1[0] = x1[0] * cs0[0] - x2[0] * cs0[1]; o2[0] = x2[0] * cs0[0] + x1[0] * cs0[1];
                        o1[1] = x1[1] * cs0[2] - x2[1] * cs0[3]; o2[1] = x2[1] * cs0[2] + x1[1] * cs0[3];
                        o1[2] = x1[2] * cs1[0] - x2[2] * cs1[1]; o2[2] = x2[2] * cs1[0] + x1[2] * cs1[1];
                        o1[3] = x1[3] * cs1[2] - x2[3] * cs1[3]; o2[3] = x2[3] * cs1[2] + x1[3] * cs1[3];
                        const int col = region * 1024 + ((u.pn & 3) * 2 + bj) * 128 + 16 * wc + 4 * fq;
                        *(u32x2*)(zr + col) = pack4(o1); *(u32x2*)(zr + col + 64) = pack4(o2);
                    }
                } else {
                    float ss = 0.f;
#pragma unroll
                    for (int bj = 0; bj < 2; ++bj) {
                        f32x4 v0 = acc[ai][bj][m][0] * rs, v1 = acc[ai][bj][m][1] * rs;
                        if (region == 3) { v0 = silu4(v0); v1 = silu4(v1); }
                        else if (region >= 4) { v0 = gelu4(v0); v1 = gelu4(v1); }
                        ss += sq4(v0) + sq4(v1);
                        u32x4 w4; w4.x = cvt_pk_bf16(v0[0], v0[1]); w4.y = cvt_pk_bf16(v0[2], v0[3]); w4.z = cvt_pk_bf16(v1[0], v1[1]); w4.w = cvt_pk_bf16(v1[2], v1[3]);
                        *(u32x4*)(zr + u.pn * 256 + bj * 128 + 32 * wc + 8 * fq) = w4;
                    }
                    if (region == 5) { ss += __shfl_xor(ss, 16); ss += __shfl_xor(ss, 32); if (fq == 0) ssqv[(size_t)row * 16 + (u.pn - 20) * 4 + wc] = ss; }
                }
            }
    }
};

template <bool DOWN> struct EpiRes {
    static constexpr bool PERM = true, AFTER_DRAIN = false, PERMA = false;
    const float* xp; const float* xs; float* X1; bf16_t* X1B; float* ssq;
    DI void operator()(const f32x4 (&acc)[2][2][4][2], const pg8::Unit& u, int wr, int wc, int fr, int fq) const {
#pragma unroll
        for (int ai = 0; ai < 2; ++ai)
#pragma unroll
            for (int m = 0; m < 4; ++m) {
                const int row = u.pm * 256 + ai * 128 + wr * 64 + m * 16 + fr;
                float ss = 0.f;
#pragma unroll
                for (int bj = 0; bj < 2; ++bj) {
                    const int col = u.pn * 256 + bj * 128 + 32 * wc + 8 * fq;
                    f32x4 b0, b1;
                    if (DOWN) { const u32x4 xb = *(const u32x4*)(X1B + (size_t)row * DM + col); b0[0] = bf_lo(xb.x); b0[1] = bf_hi(xb.x); b0[2] = bf_lo(xb.y); b0[3] = bf_hi(xb.y); b1[0] = bf_lo(xb.z); b1[1] = bf_hi(xb.z); b1[2] = bf_lo(xb.w); b1[3] = bf_hi(xb.w); }
                    else { const u32x4 xb = *(const u32x4*)((const bf16_t*)xp + (size_t)row * DM + col); b0[0] = bf_lo(xb.x); b0[1] = bf_hi(xb.x); b0[2] = bf_lo(xb.y); b0[3] = bf_hi(xb.y); b1[0] = bf_lo(xb.z); b1[1] = bf_hi(xb.z); b1[2] = bf_lo(xb.w); b1[3] = bf_hi(xb.w); }
                    const f32x4 v0 = acc[ai][bj][m][0] + b0, v1 = acc[ai][bj][m][1] + b1;
                    ss += sq4(v0) + sq4(v1);
                    if (DOWN) { u32x4 w4; w4.x = cvt_pk_bf16(v0[0], v0[1]); w4.y = cvt_pk_bf16(v0[2], v0[3]); w4.z = cvt_pk_bf16(v1[0], v1[1]); w4.w = cvt_pk_bf16(v1[2], v1[3]);
                        *(u32x4*)((bf16_t*)X1 + (size_t)row * DM + col) = w4; }
                    if (!DOWN) { u32x4 w4; w4.x = cvt_pk_bf16(v0[0], v0[1]); w4.y = cvt_pk_bf16(v0[2], v0[3]); w4.z = cvt_pk_bf16(v1[0], v1[1]); w4.w = cvt_pk_bf16(v1[2], v1[3]);
                        *(u32x4*)(X1B + (size_t)row * DM + col) = w4; }
                }
                ss += __shfl_xor(ss, 16); ss += __shfl_xor(ss, 32);
                if (fq == 0) ssq[(size_t)row * 32 + u.pn * 4 + wc] = ss;
            }
    }
};

struct EpiUp {
    static constexpr bool PERM = true, AFTER_DRAIN = false, PERMA = true;
    bf16_t* ACT; float* HALO; const float* ssq2; const float* convw; const float* convb; LAS float* ex;
    DI void operator()(const f32x4 (&acc)[2][2][4][2], const pg8::Unit& u, int wr, int wc, int fr, int fq) const {
        asm volatile("" : "+v"(fr), "+v"(fq));
        asm volatile("" : "+s"(wr), "+s"(wc));
        const int lane = fq * 16 + fr;
        const int tcol = 32 * wc + 8 * fq;
        float rs[2][4];
#pragma unroll
        for (int ai = 0; ai < 2; ++ai) {
#pragma unroll
            for (int m = 0; m < 4; ++m) {
                const int row = u.pm * 256 + ai * 128 + wr * 64 + 4 * fr + m;
                const f32x4* p = (const f32x4*)(ssq2 + (size_t)row * 32 + fq * 8);
                float s = sum4(p[0]) + sum4(p[1]);
                s += __shfl_xor(s, 16); s += __shfl_xor(s, 32);
                rs[ai][m] = rsqrtf(s * (1.0f / DM) + EPS);
            }
            const int b = 2 * ai + wr;
            if (fr == 0 || fr == 15) {
                const bool lo = fr == 0;
#pragma unroll
                for (int bj = 0; bj < 2; ++bj)
#pragma unroll
                    for (int n = 0; n < 2; ++n) {
                        const f32x4 a0 = acc[ai][bj][0][n] * rs[ai][0], a3 = acc[ai][bj][3][n] * rs[ai][3];
                        f32x4 val; val[0] = lo ? a0[0] : a3[0]; val[1] = lo ? a0[1] : a3[1]; val[2] = lo ? a0[2] : a3[2]; val[3] = lo ? a0[3] : a3[3];
                        *(LAS f32x4*)(ex + (b * 2 + (lo ? 0 : 1)) * 256 + bj * 128 + tcol + 4 * n) = val;
                    }
            }
        }
        {
            const bool hfirst = (wr == 0 && fr == 0), hlast = (wr == 1 && fr == 15);
            if (hfirst || hlast) {
#pragma unroll
                for (int k = 0; k < 2; ++k)
#pragma unroll
                    for (int bj = 0; bj < 2; ++bj)
#pragma unroll
                        for (int n = 0; n < 2; ++n) {
                            const f32x4 a0 = acc[0][bj][k][n] * rs[0][k], a1 = acc[1][bj][2 + k][n] * rs[1][2 + k];
                            f32x4 val; val[0] = hfirst ? a0[0] : a1[0]; val[1] = hfirst ? a0[1] : a1[1]; val[2] = hfirst ? a0[2] : a1[2]; val[3] = hfirst ? a0[3] : a1[3];
                            *(f32x4*)(HALO + (size_t)(u.pm * 4 + (hfirst ? k : 2 + k)) * FF2 + u.pn * 256 + bj * 128 + tcol + 4 * n) = val;
                        }
            }
        }
        LBAR();
        const int src_dn = (lane & 48) | ((fr + 15) & 15), src_up = (lane & 48) | ((fr + 1) & 15);
#pragma unroll
        for (int n = 0; n < 2; ++n) {
            const int ca = u.pn * 128 + tcol + 4 * n;
            f32x4 cw[2][4];
#pragma unroll
            for (int bj = 0; bj < 2; ++bj) { cw[bj][0] = *(const f32x4*)(convw + ca + bj * FF); cw[bj][1] = *(const f32x4*)(convw + FF2 + ca + bj * FF); cw[bj][2] = *(const f32x4*)(convw + 2 * FF2 + ca + bj * FF); cw[bj][3] = *(const f32x4*)(convb + ca + bj * FF); }
#pragma unroll
            for (int ai = 0; ai < 2; ++ai) {
                const int b = 2 * ai + wr;
                f32x4 cva[4], outv[4];
#pragma unroll
                for (int bj = 0; bj < 2; ++bj) {
                    f32x4 v[4];
#pragma unroll
                    for (int m = 0; m < 4; ++m) v[m] = acc[ai][bj][m][n] * rs[ai][m];
                    f32x4 prevv, nextv;
#pragma unroll
                    for (int i = 0; i < 4; ++i) {
                        prevv[i] = __uint_as_float((unsigned)__builtin_amdgcn_update_dpp(0, (int)__float_as_uint(v[3][i]), 0x111, 0xf, 0xf, false));
                        nextv[i] = __uint_as_float((unsigned)__builtin_amdgcn_update_dpp(0, (int)__float_as_uint(v[0][i]), 0x101, 0xf, 0xf, false));
                    }
                    if (fr == 0) prevv = *(const LAS f32x4*)(ex + (((b > 0 ? b - 1 : 0)) * 2 + 1) * 256 + bj * 128 + tcol + 4 * n);
                    if (fr == 15) nextv = *(const LAS f32x4*)(ex + (((b < 3 ? b + 1 : 3)) * 2 + 0) * 256 + bj * 128 + tcol + 4 * n);
#pragma unroll
                    for (int m = 0; m < 4; ++m) {
                        const f32x4 pv = m == 0 ? prevv : v[m > 0 ? m - 1 : 0], nv = m == 3 ? nextv : v[m < 3 ? m + 1 : 3];
                        const f32x4 cv = cw[bj][0] * pv + cw[bj][1] * v[m] + cw[bj][2] * nv + cw[bj][3];
                        if (bj == 0) cva[m] = cv;
                        else {
                            outv[m] = silu4(cva[m]) * cv;
                        }
                    }
                }
#pragma unroll
                for (int m = 0; m < 4; ++m) {
                    const int tr = ai * 128 + wr * 64 + 4 * fr + m;
                    if (tr != 0 && tr != 255) *(u32x2*)(ACT + (size_t)(u.pm * 256 + tr) * FF + ca) = pack4(outv[m]);
                }
                __builtin_amdgcn_sched_barrier(0);
            }
        }
    }
};

DI void tr_load(f32x4 (&v)[16], const float* W, int N, int kb, int nb, int lane) {
    const int k0 = 64 * kb, n0 = 64 * nb;
#pragma unroll
    for (int i = 0; i < 16; ++i) v[i] = *(const f32x4*)(W + (size_t)(k0 + 4 * i + (lane >> 4)) * N + n0 + 4 * (lane & 15));
}
template <bool SCALE> DI void tr_finish(const f32x4 (&v)[16], const float (&ks)[16], int K, bf16_t* WT, int mode, LAS float* scr, int kb, int nb, int lane) {
    const int k0 = 64 * kb, n0 = 64 * nb;
#pragma unroll
    for (int i = 0; i < 16; ++i) { const int kk = 4 * i + (lane >> 4); *(LAS f32x4*)(scr + kk * 68 + 4 * (lane & 15)) = SCALE ? v[i] * ks[i] : v[i]; }
    asm volatile("s_waitcnt lgkmcnt(0)" ::: "memory");
    const int ncol = n0 + lane;
    int prow = ncol; float sc = 1.f;
    if (mode == 1) { const int region = ncol >> 10; if (region < 2) { const int cc = ncol & 127; prow = (ncol & ~127) + 32 * ((cc >> 4) & 3) + 8 * ((cc >> 2) & 3) + 4 * (cc >> 6) + (cc & 3); if (region == 0) sc = 0.08838834764831845f; } }
    else if (mode == 2) { if (ncol < FF) prow = 256 * (ncol >> 7) + (ncol & 127); else { const int nn = ncol - FF; prow = 256 * (nn >> 7) + 128 + (nn & 127); } }
    bf16_t* orow = WT + (size_t)prow * K + k0;
#pragma unroll
    for (int j = 0; j < 8; ++j) {
        const LAS float* sp = scr + (8 * j) * 68 + lane;
        u32x4 o; o.x = cvt_pk_bf16(sp[0 * 68] * sc, sp[1 * 68] * sc); o.y = cvt_pk_bf16(sp[2 * 68] * sc, sp[3 * 68] * sc); o.z = cvt_pk_bf16(sp[4 * 68] * sc, sp[5 * 68] * sc); o.w = cvt_pk_bf16(sp[6 * 68] * sc, sp[7 * 68] * sc);
        *(u32x4*)(orow + 8 * j) = o;
    }
    asm volatile("s_waitcnt lgkmcnt(0)" ::: "memory");
}
template <bool SCALE> DI void tr_pair(const float* W, int K, int N, bf16_t* WT, const float* kscale, int mode, LAS float* scr, int kb0, int nb, int lane) {
    float ksa[16], ksb[16];
#pragma unroll
    for (int i = 0; i < 16; ++i) { ksa[i] = SCALE ? kscale[64 * kb0 + 4 * i + (lane >> 4)] : 1.f; ksb[i] = SCALE ? kscale[64 * kb0 + 64 + 4 * i + (lane >> 4)] : 1.f; }
    f32x4 va[16], vb[16];
    tr_load(va, W, N, kb0, nb, lane); tr_load(vb, W, N, kb0 + 1, nb, lane);
    tr_finish<SCALE>(va, ksa, K, WT, mode, scr, kb0, nb, lane);
    tr_finish<SCALE>(vb, ksb, K, WT, mode, scr, kb0 + 1, nb, lane);
}

typedef short s16x4 __attribute__((ext_vector_type(4)));
DI bf16x8 tr_frag(const LAS bf16_t* tile, int pitch, int tok0, int f0, int lane) {
    const int i = lane & 15, q = i >> 2, p = i & 3, fq = lane >> 4;
    LAS bf16_t* a = (LAS bf16_t*)tile + (tok0 + 8 * fq + q) * pitch + f0 + 4 * p;
    const s16x4 lo = __builtin_amdgcn_ds_read_tr16_b64_v4i16((LAS s16x4*)a);
    const s16x4 hi = __builtin_amdgcn_ds_read_tr16_b64_v4i16((LAS s16x4*)(a + 4 * pitch));
    return __builtin_shufflevector(lo, hi, 0, 1, 2, 3, 4, 5, 6, 7);
}
constexpr int VP = 40;

DI void scan_item(LAS unsigned char* lds, int item, const bf16_t* Z, bf16_t* crossF, bf16_t* crossB, const float* lgf, const float* lgb) {
    const int tid = threadIdx.x, lane = tid & 63, w = tid >> 6, fr = lane & 15, fq = lane >> 4;
    const int sidx = item >> 6, rem = item & 63, h = rem >> 3, dir = (rem >> 2) & 1, sl = rem & 3;
    const int rowbase = sidx == 0 ? 8192 : (sidx == 1 ? 0 : 4096), nch = sidx == 0 ? 64 : 32;
    const float l2g = (dir ? lgb[h] : lgf[h]) * LOG2E;
    const float decay = exp2f(l2g * 128.f);
    bf16_t* cross = dir ? crossB : crossF;
    LAS bf16_t* Qn = (LAS bf16_t*)lds; LAS bf16_t* Kn = Qn + 128 * TP; LAS bf16_t* Vn = Kn + 128 * TP; LAS bf16_t* Rt = Vn + 128 * VP;
    f32x4 racc[2]; racc[0] = (f32x4){0.f, 0.f, 0.f, 0.f}; racc[1] = racc[0];
    const int vr = tid >> 2, vc = tid & 3;
    const float zeta = exp2f(l2g * (float)(dir ? vr : 127 - vr));
    const int n = 16 * w + fr;
    const float xi = exp2f(l2g * (float)(dir ? 128 - n : n + 1));
    const bf16_t* zbase = Z + (size_t)rowbase * INC + h * 128;
    u32x4 qA[4], kA[4], vA, qB[4], kB[4], vB, qC[4], kC[4], vC, qD[4], kD[4], vD;
#define SC_LOAD(Q_, K_, V_, s_) do { const int c_ = dir ? nch - 1 - (s_) : (s_); const bf16_t* zb = zbase + (size_t)c_ * 128 * INC; \
        _Pragma("unroll") for (int i = 0; i < 4; ++i) { const int v = tid + 512 * i; Q_[i] = *(const u32x4*)(zb + (size_t)(v >> 4) * INC + (v & 15) * 8); K_[i] = *(const u32x4*)(zb + (size_t)(v >> 4) * INC + 1024 + (v & 15) * 8); } \
        V_ = *(const u32x4*)(zb + (size_t)vr * INC + 2048 + sl * 32 + vc * 8); } while (0)
#define SC_STEP(Q_, K_, V_, s_) do { const int c_ = dir ? nch - 1 - (s_) : (s_); const int row0 = rowbase + c_ * 128; \
        _Pragma("unroll") for (int i = 0; i < 4; ++i) { const int v = tid + 512 * i; *(LAS u32x4*)(Qn + (v >> 4) * TP + (v & 15) * 8) = Q_[i]; *(LAS u32x4*)(Kn + (v >> 4) * TP + (v & 15) * 8) = K_[i]; } \
        { u32x4 o; _Pragma("unroll") for (int e = 0; e < 4; ++e) o[e] = cvt_pk_bf16(bf_lo(V_[e]) * zeta, bf_hi(V_[e]) * zeta); *(LAS u32x4*)(Vn + vr * VP + vc * 8) = o; } \
        _Pragma("unroll") for (int t = 0; t < 2; ++t) *(LAS u32x2*)(Rt + (16 * t + fr) * TP + 16 * w + 4 * fq) = pack4(racc[t]); \
        LBAR(); \
        if ((s_) + 4 < nch) SC_LOAD(Q_, K_, V_, (s_) + 4); \
        bf16x8 qf[4]; \
        _Pragma("unroll") for (int ks = 0; ks < 4; ++ks) qf[ks] = *(const LAS bf16x8*)(Qn + n * TP + ks * 32 + fq * 8); \
        _Pragma("unroll") for (int t = 0; t < 2; ++t) { f32x4 ca = {0.f, 0.f, 0.f, 0.f}; \
            _Pragma("unroll") for (int ks = 0; ks < 4; ++ks) { const bf16x8 rf = *(const LAS bf16x8*)(Rt + (16 * t + fr) * TP + ks * 32 + fq * 8); ca = MFMA16(rf, qf[ks], ca); } \
            *(u32x2*)(cross + (size_t)(row0 + n) * RW + h * 128 + sl * 32 + 16 * t + 4 * fq) = pack4(ca * xi); } \
        racc[0] = racc[0] * decay; racc[1] = racc[1] * decay; \
        _Pragma("unroll") for (int ks = 0; ks < 4; ++ks) { const bf16x8 kf = tr_frag(Kn, TP, 32 * ks, 16 * w, lane); \
            _Pragma("unroll") for (int t = 0; t < 2; ++t) { const bf16x8 vf = tr_frag(Vn, VP, 32 * ks, 16 * t, lane); racc[t] = MFMA16(kf, vf, racc[t]); } } \
        LBAR(); } while (0)
    SC_LOAD(qA, kA, vA, 0); SC_LOAD(qB, kB, vB, 1); SC_LOAD(qC, kC, vC, 2); SC_LOAD(qD, kD, vD, 3);
    for (int step = 0; step < nch; step += 4) { SC_STEP(qA, kA, vA, step); SC_STEP(qB, kB, vB, step + 1); SC_STEP(qC, kC, vC, step + 2); SC_STEP(qD, kD, vD, step + 3); }
#undef SC_LOAD
#undef SC_STEP
}

DI void sgu_item(LAS unsigned char* lds, int item, const bf16_t* Z, const float* ssqv, const float* normw, const bf16_t* wsb, const float* sgub, bf16_t* MIX) {
    const int tid = threadIdx.x, lane = tid & 63, w = tid >> 6, fr = lane & 15, fq = lane >> 4;
    const int chunk = item >> 3, g = item & 7, row0 = chunk * 128;
    LAS bf16_t* Wsl = (LAS bf16_t*)lds; LAS bf16_t* vt = Wsl + 128 * TP;
    const int tr = tid & 127, tc = tid >> 7;
    u32x4 wv[4], zv[4]; f32x4 nw[4][2];
#pragma unroll
    for (int i = 0; i < 4; ++i) { const int v = tid + 512 * i; wv[i] = *(const u32x4*)(wsb + (size_t)g * 16384 + (size_t)v * 8); }
#pragma unroll
    for (int i = 0; i < 4; ++i) { const int c8 = tc + 4 * i; zv[i] = *(const u32x4*)(Z + (size_t)(row0 + tr) * INC + 5 * 1024 + g * 128 + c8 * 8);
        nw[i][0] = *(const f32x4*)(normw + g * 128 + c8 * 8); nw[i][1] = *(const f32x4*)(normw + g * 128 + c8 * 8 + 4); }
    const f32x4* sp = (const f32x4*)(ssqv + (size_t)(row0 + tr) * 16);
    const float ss = sum4(sp[0]) + sum4(sp[1]) + sum4(sp[2]) + sum4(sp[3]);
    const int n = 16 * w + fr, row = row0 + n;
    const float bn = sgub[g * 128 + n];
    u32x2 uu[8];
#pragma unroll
    for (int db = 0; db < 8; ++db) uu[db] = *(const u32x2*)(Z + (size_t)row * INC + 4 * 1024 + g * 128 + 16 * db + 4 * fq);
    const float rsv = rsqrtf(ss * (1.0f / 1024.f) + EPS);
#pragma unroll
    for (int i = 0; i < 4; ++i) { const int v = tid + 512 * i; *(LAS u32x4*)(Wsl + (v >> 4) * TP + (v & 15) * 8) = wv[i]; }
#pragma unroll
    for (int i = 0; i < 4; ++i) {
        const int c8 = tc + 4 * i;
#pragma unroll
        for (int e = 0; e < 8; e += 2) {
            const unsigned wd = zv[i][e >> 1]; const float s0 = nw[i][e >> 2][e & 3] * rsv, s1 = nw[i][e >> 2][(e + 1) & 3] * rsv;
            const unsigned pk = cvt_pk_bf16(bf_lo(wd) * s0, bf_hi(wd) * s1);
            vt[(c8 * 8 + e) * TP + tr] = (unsigned short)(pk & 0xffffu); vt[(c8 * 8 + e + 1) * TP + tr] = (unsigned short)(pk >> 16);
        }
    }
    LBAR();
    bf16x8 wf[4];
#pragma unroll
    for (int ks = 0; ks < 4; ++ks) wf[ks] = *(const LAS bf16x8*)(Wsl + n * TP + ks * 32 + fq * 8);
#pragma unroll
    for (int db = 0; db < 8; ++db) {
        f32x4 s = {0.f, 0.f, 0.f, 0.f};
#pragma unroll
        for (int ks = 0; ks < 4; ++ks) { const bf16x8 vf = *(const LAS bf16x8*)(vt + (16 * db + fr) * TP + ks * 32 + fq * 8); s = MFMA16(vf, wf[ks], s); }
        const int col = g * 128 + 16 * db + 4 * fq;
        f32x4 o; o[0] = bf_lo(uu[db].x) * (s[0] + bn); o[1] = bf_hi(uu[db].x) * (s[1] + bn); o[2] = bf_lo(uu[db].y) * (s[2] + bn); o[3] = bf_hi(uu[db].y) * (s[3] + bn);
        *(u32x2*)(MIX + (size_t)row * DM + 1024 + col) = pack4(o);
    }
    LBAR();
}

DI void inner_phase(LAS unsigned char* lds, int bid, int G, const bf16_t* Z, const bf16_t* crossF, const bf16_t* crossB, const float* gnw, const float* lgf, const float* lgb, bf16_t* MIX) {
    const int tid = threadIdx.x, lane = tid & 63, w = tid >> 6, fr = lane & 15, fq = lane >> 4;
    LAS bf16_t* Qs = (LAS bf16_t*)lds; LAS bf16_t* Ks = Qs + 128 * TP; LAS bf16_t* Vt = Ks + 128 * TP;
    const int tr = tid & 127, tc = tid >> 7;
    u32x4 qr[4], kr[4], vr[4];
#define IN_LOAD(it_) do { const bf16_t* zb = Z + (size_t)((it_) >> 3) * 128 * INC + ((it_) & 7) * 128; \
        _Pragma("unroll") for (int i = 0; i < 4; ++i) { const int v = tid + 512 * i; const bf16_t* zp = zb + (size_t)(v >> 4) * INC + (v & 15) * 8; qr[i] = *(const u32x4*)zp; kr[i] = *(const u32x4*)(zp + 1024); \
            vr[i] = *(const u32x4*)(zb + (size_t)tr * INC + 2048 + (tc + 4 * i) * 8); } } while (0)
    if (bid < 1024) IN_LOAD(bid);
    for (int item = bid; item < 1024; item += G) {
        const int chunk = item >> 3, h = item & 7, row0 = chunk * 128;
#pragma unroll
        for (int i = 0; i < 4; ++i) { const int v = tid + 512 * i; const int o = (v >> 4) * TP + (v & 15) * 8; *(LAS u32x4*)(Qs + o) = qr[i]; *(LAS u32x4*)(Ks + o) = kr[i];
#pragma unroll
            for (int e = 0; e < 8; ++e) { const int c8 = tc + 4 * i; Vt[(32 * (c8 >> 2) + 16 * (e >> 2) + 4 * (c8 & 3) + (e & 3)) * TP + tr] = u16_of(vr[i], e); } }
        LBAR();
        const float l2f = lgf[h] * LOG2E, l2b = lgb[h] * LOG2E;
        const int n = 16 * w + fr, row = row0 + n;
        u32x4 cf[4], cb[4], gg[4];
#pragma unroll
        for (int a4 = 0; a4 < 4; ++a4) { const int col = h * 128 + 32 * a4 + 8 * fq; cf[a4] = *(const u32x4*)(crossF + (size_t)row * RW + col); cb[a4] = *(const u32x4*)(crossB + (size_t)row * RW + col);
            gg[a4] = *(const u32x4*)(Z + (size_t)row * INC + 3 * 1024 + col); }
        asm volatile("" ::: "memory");
        if (item + G < 1024) IN_LOAD(item + G);
        bf16x8 qf[4];
#pragma unroll
        for (int ks = 0; ks < 4; ++ks) qf[ks] = *(const LAS bf16x8*)(Qs + n * TP + ks * 32 + fq * 8);
        asm volatile("s_waitcnt lgkmcnt(0)" ::: "memory");
#pragma unroll
        for (int mb = 0; mb < 8; ++mb) {
            f32x4 s = {0.f, 0.f, 0.f, 0.f};
#pragma unroll
            for (int ks = 0; ks < 4; ++ks) { const bf16x8 kf = *(const LAS bf16x8*)(Ks + (16 * mb + fr) * TP + ks * 32 + fq * 8); s = MFMA16(kf, qf[ks], s); }
#pragma unroll
            for (int r = 0; r < 4; ++r) { const int d = n - (16 * mb + 4 * fq + r); s[r] *= d >= 0 ? exp2f(l2f * (float)d) : exp2f(l2b * (float)(-d)); }
            *(LAS u32x2*)(Qs + n * TP + 16 * mb + 4 * fq) = pack4(s);
        }
        asm volatile("s_waitcnt lgkmcnt(0)" ::: "memory");
        bf16x8 wf[4];
#pragma unroll
        for (int ks = 0; ks < 4; ++ks) wf[ks] = *(const LAS bf16x8*)(Qs + n * TP + ks * 32 + fq * 8);
        f32x4 o[8]; float sm = 0.f;
#pragma unroll
        for (int eb = 0; eb < 8; ++eb) {
            f32x4 a = {0.f, 0.f, 0.f, 0.f};
#pragma unroll
            for (int ks = 0; ks < 4; ++ks) { const bf16x8 vf = *(const LAS bf16x8*)(Vt + (16 * eb + fr) * TP + ks * 32 + fq * 8); a = MFMA16(vf, wf[ks], a); }
            { const unsigned f0 = cf[eb >> 1][2 * (eb & 1)], f1 = cf[eb >> 1][2 * (eb & 1) + 1], b0 = cb[eb >> 1][2 * (eb & 1)], b1 = cb[eb >> 1][2 * (eb & 1) + 1];
              a[0] += bf_lo(f0) + bf_lo(b0); a[1] += bf_hi(f0) + bf_hi(b0); a[2] += bf_lo(f1) + bf_lo(b1); a[3] += bf_hi(f1) + bf_hi(b1); }
            o[eb] = a; sm += sum4(a);
        }
        sm += __shfl_xor(sm, 16); sm += __shfl_xor(sm, 32);
        const float mean = sm * (1.0f / 128.f); float vs = 0.f;
#pragma unroll
        for (int eb = 0; eb < 8; ++eb) { o[eb] = o[eb] - mean; vs += sq4(o[eb]); }
        vs += __shfl_xor(vs, 16); vs += __shfl_xor(vs, 32);
        const float rstd = rsqrtf(vs * (1.0f / 128.f) + EPS);
#pragma unroll
        for (int a4 = 0; a4 < 4; ++a4) {
            const int col = h * 128 + 32 * a4 + 8 * fq;
            const f32x4 gw0 = *(const f32x4*)(gnw + col), gw1 = *(const f32x4*)(gnw + col + 4);
            const u32x4 g4 = gg[a4]; const f32x4 o0 = o[2 * a4], o1 = o[2 * a4 + 1];
            f32x4 r0, r1;
            r0[0] = bf_lo(g4.x) * (o0[0] * rstd * gw0[0]); r0[1] = bf_hi(g4.x) * (o0[1] * rstd * gw0[1]); r0[2] = bf_lo(g4.y) * (o0[2] * rstd * gw0[2]); r0[3] = bf_hi(g4.y) * (o0[3] * rstd * gw0[3]);
            r1[0] = bf_lo(g4.z) * (o1[0] * rstd * gw1[0]); r1[1] = bf_hi(g4.z) * (o1[1] * rstd * gw1[1]); r1[2] = bf_lo(g4.w) * (o1[2] * rstd * gw1[2]); r1[3] = bf_hi(g4.w) * (o1[3] * rstd * gw1[3]);
            u32x4 w4; w4.x = cvt_pk_bf16(r0[0], r0[1]); w4.y = cvt_pk_bf16(r0[2], r0[3]); w4.z = cvt_pk_bf16(r1[0], r1[1]); w4.w = cvt_pk_bf16(r1[2], r1[3]);
            *(u32x4*)(MIX + (size_t)row * DM + col) = w4;
        }
        LBAR();
    }
#undef IN_LOAD
}

struct Args { const float* in[17]; float* out; unsigned char* ws; };

#define XB_TMO      128
#define XB_XCNT(j)  (256  + 64 * (j))
#define XB_XSUB(j)  (1280 + 64 * (j))
#define XB_XGEN(j)  (2304 + 64 * (j))
#define XB_TOP      3328
#define XB_TOPGEN   3392
#define XCD_BAR_WORDS 3456
#define XB_SPIN_CAP (1u << 18)

__device__ __forceinline__ unsigned xb_ld(unsigned* p)              { return __hip_atomic_load(p, __ATOMIC_RELAXED, __HIP_MEMORY_SCOPE_AGENT); }
__device__ __forceinline__ unsigned xb_add(unsigned* p, unsigned v) { return __hip_atomic_fetch_add(p, v, __ATOMIC_RELAXED, __HIP_MEMORY_SCOPE_AGENT); }
__device__ __forceinline__ unsigned xb_xcc_id() { return (unsigned)__builtin_amdgcn_s_getreg((3 << 11) | 20) & 0xFu; }
#define XB_SPIN(cond, bar) do { unsigned _sp = 0; while (cond) { __builtin_amdgcn_s_sleep(1); \
    if ((++_sp & 255u) == 0u) { if (xb_ld(&(bar)[XB_TMO])) break; if (_sp > XB_SPIN_CAP) { atomicAdd(&(bar)[XB_TMO], 1u); break; } } } } while (0)

struct XcdBarrier {
    unsigned* bar; unsigned x;
    volatile LAS unsigned* st;
};

__device__ __forceinline__ XcdBarrier xcd_barrier_post(unsigned* bar, volatile LAS unsigned* st) {
    XcdBarrier b; b.bar = bar; b.x = xb_xcc_id(); b.st = st;
    if (threadIdx.x == 0) (void)xb_add(&bar[XB_XCNT(b.x)], 1u);
    return b;
}
__device__ __forceinline__ void xcd_barrier_complete(unsigned* bar, unsigned x, unsigned& nloc, unsigned& nx) {
    const unsigned G = gridDim.x * gridDim.y * gridDim.z;
    unsigned sum, cnt, mine, sp = 0u;
    for (;;) {
        sum = 0u; cnt = 0u; mine = 0u;
#pragma unroll
        for (unsigned j = 0; j < 16; ++j) { const unsigned c = xb_ld(&bar[XB_XCNT(j)]); sum += c; cnt += (c > 0u) ? 1u : 0u; mine = (j == x) ? c : mine; }
        if (sum == G) break;
        __builtin_amdgcn_s_sleep(1);
        if ((++sp & 255u) == 0u) { if (xb_ld(&bar[XB_TMO])) break; if (sp > XB_SPIN_CAP) { atomicAdd(&bar[XB_TMO], 1u); break; } }
    }
    nloc = mine > 0u ? mine : 1u; nx = cnt > 0u ? cnt : 1u;
}

__device__ __forceinline__ void xcd_barrier(const XcdBarrier& b) {
    asm volatile("s_waitcnt vmcnt(0)" ::: "memory");
    __syncthreads();
    if (threadIdx.x == 0) {
        unsigned* bar = b.bar;
        __builtin_amdgcn_s_waitcnt(0);
        unsigned nloc = b.st[0], nx = b.st[1];
        if (nloc == 0u) { xcd_barrier_complete(bar, b.x, nloc, nx); b.st[0] = nloc; b.st[1] = nx; }
        const unsigned old = xb_add(&bar[XB_XSUB(b.x)], 1u);
        const unsigned gen = old / nloc;
        if (old + 1u == (gen + 1u) * nloc) {
            __builtin_amdgcn_fence(__ATOMIC_RELEASE, "agent");
            asm volatile("s_waitcnt vmcnt(0)" ::: "memory");
            const unsigned og = xb_add(&bar[XB_TOP], 1u);
            const unsigned tg = og / nx;
            if (og + 1u == (tg + 1u) * nx) xb_add(&bar[XB_TOPGEN], 1u);
            else XB_SPIN(xb_ld(&bar[XB_TOPGEN]) == tg, bar);
            __builtin_amdgcn_fence(__ATOMIC_ACQUIRE, "agent");
            xb_add(&bar[XB_XGEN(b.x)], 1u);
            asm volatile("s_waitcnt vmcnt(0)" ::: "memory");
        } else {
            XB_SPIN(xb_ld(&bar[XB_XGEN(b.x)]) == gen, bar);
            __builtin_amdgcn_fence(__ATOMIC_ACQUIRE, "agent");
            asm volatile("s_waitcnt vmcnt(0)" ::: "memory");
        }
    }
    __syncthreads();
}

#if REP_MASK
#define STAMP(k) do { if (blockIdx.x == 0 && threadIdx.x == 0) ((volatile LAS unsigned*)(lds + MISC_OFF + 64))[k] = (unsigned)__builtin_amdgcn_s_memrealtime(); } while (0)
#else
#define STAMP(k) do { } while (0)
#endif
__global__ void __launch_bounds__(512, 2) fwd_kernel(Args a) {
    extern __shared__ __attribute__((aligned(16))) unsigned char lds_raw[];
    LAS unsigned char* lds = (LAS unsigned char*)lds_raw;
    const int tid = threadIdx.x, lane = tid & 63, wave = __builtin_amdgcn_readfirstlane(tid >> 6);
    const int G = gridDim.x, bid = blockIdx.x;
    unsigned char* ws = a.ws;
    const float* xp = a.in[0]; const float* xs = a.in[1];
    bf16_t* Win_t = (bf16_t*)(ws + WS_WIN); bf16_t* Wout_t = (bf16_t*)(ws + WS_WOUT); bf16_t* Wup_t = (bf16_t*)(ws + WS_WUP); bf16_t* Wdown_t = (bf16_t*)(ws + WS_WDOWN);
    bf16_t* Zb = (bf16_t*)(ws + WS_Z); bf16_t* X1B = (bf16_t*)(ws + WS_X1B); bf16_t* ACT = (bf16_t*)(ws + WS_ACT); bf16_t* MIX = (bf16_t*)(ws + WS_MIX);
    float* HALO = (float*)(ws + WS_HALO); float* ROPE = (float*)(ws + WS_ROPE); float* RS1 = (float*)(ws + WS_RS1);
    float* SSQV = (float*)(ws + WS_SSQV); float* SSQ2 = (float*)(ws + WS_SSQ2); float* SSQ3 = (float*)(ws + WS_SSQ3);
    unsigned* CTL = (unsigned*)(ws + WS_CTL);
    bf16_t* X2B = (bf16_t*)(ws + WS_X1B);
    bf16_t* WSB = (bf16_t*)(ws + 335 * MiB);
    { volatile LAS unsigned* st_ = (volatile LAS unsigned*)(lds + MISC_OFF + 128); if (tid == 0) { st_[0] = 0u; st_[1] = 0u; } }
    __syncthreads();
    const XcdBarrier xbar = xcd_barrier_post(CTL + 1024, (volatile LAS unsigned*)(lds + MISC_OFF + 128));
    bf16_t* XB = (bf16_t*)a.out; bf16_t* crossF = (bf16_t*)a.out + (size_t)T * DM; bf16_t* crossB = crossF + (size_t)T * RW; float* X1 = a.out;

    STAMP(0);
    if (PH_MASK & 1) {
        LAS float* scr = (LAS float*)(lds + wave * 17408);
        const int gw = bid * 8 + wave, NGW = G * 8;
        for (int it = gw; it < (DM / 128) * (INC / 64); it += NGW) tr_pair<true>(a.in[3], DM, INC, Win_t, a.in[2], 1, scr, 2 * (it / (INC / 64)), it % (INC / 64), lane);
        for (int row = gw; row < T; row += 2 * NGW) {
            const int row2 = row + NGW;
            const float* xr = row < 8192 ? xp + (size_t)row * DM : xs + (size_t)(row - 8192) * DM;
            const float* xr2 = row2 < 8192 ? xp + (size_t)row2 * DM : xs + (size_t)(row2 - 8192) * DM;
            f32x4 v[8], u[8]; float s = 0.f, s2 = 0.f;
#pragma unroll
            for (int j = 0; j < 8; ++j) v[j] = *(const f32x4*)(xr + 256 * j + 4 * lane);
#pragma unroll
            for (int j = 0; j < 8; ++j) u[j] = *(const f32x4*)(xr2 + 256 * j + 4 * lane);
#pragma unroll
            for (int j = 0; j < 8; ++j) { s += sq4(v[j]); s2 += sq4(u[j]); }
            s = wave_sum(s); s2 = wave_sum(s2);
            if (lane == 0) { RS1[row] = rsqrtf(s * (1.0f / DM) + EPS); RS1[row2] = rsqrtf(s2 * (1.0f / DM) + EPS); }
#pragma unroll
            for (int j = 0; j < 8; ++j) { *(u32x2*)(XB + (size_t)row * DM + 256 * j + 4 * lane) = pack4(v[j]); *(u32x2*)(XB + (size_t)row2 * DM + 256 * j + 4 * lane) = pack4(u[j]); }
        }
        for (int e = bid * 512 + tid; e < 8 * 128 * 128 / 4; e += G * 512) *(u32x2*)(WSB + 4 * (size_t)e) = pack4(*(const f32x4*)(a.in[8] + 4 * (size_t)e));
        const float inv = (float)exp2(-(double)(tid & 63) * (13.287712379549449 / 64.0));
        for (int e = bid * 512 + tid; e < 8192 * 64; e += G * 512) {
            const int pos = e >> 6;
            const float ang = (float)pos * inv;
            double rev = (double)ang * 0.15915494309189535; rev -= floor(rev);
            const float fr_ = (float)rev;
            ROPE[2 * e] = __builtin_amdgcn_cosf(fr_); ROPE[2 * e + 1] = __builtin_amdgcn_sinf(fr_);
        }
    }
    xcd_barrier(xbar); STAMP(1);

    if (PH_MASK & 2) {
        pg8::Gemm g{XB, Win_t, T, INC, DM}; pg8::StaticOrder S; S.init(T, INC, G, bid);
        EpiIn E{Zb, RS1, ROPE, SSQV};
        pg8::gemm_phase<EpiIn, pg8::StaticOrder, true, true>(lds, g, S, E);
    }
    xcd_barrier(xbar); STAMP(2);

    if (PH_MASK & 4) {
        volatile LAS int* sh = (volatile LAS int*)(lds + MISC_OFF);
        for (;;) {
            if (tid == 0) sh[0] = (int)atomicAdd(CTL, 1u);
            __syncthreads();
            const int item = sh[0];
            __syncthreads();
            if (item >= 192 + 1024 + TR_ITEMS) break;
            if (item < 192) scan_item(lds, item, Zb, crossF, crossB, a.in[4], a.in[5]);
            else if (item >= 192 + TR_ITEMS) sgu_item(lds, item - (192 + TR_ITEMS), Zb, SSQV, a.in[7], WSB, a.in[9], MIX);
            else {
                int r = item - 192; LAS float* scr = (LAS float*)(lds + wave * 17408);
                int lane_ = lane; asm volatile("" : "+v"(lane_));
                if (r < TR_OUT) tr_pair<false>(a.in[10], DM, DM, Wout_t, nullptr, 0, scr, 2 * (r >> 2), (r & 3) * 8 + wave, lane_);
                else if ((r -= TR_OUT) < TR_UP) tr_pair<true>(a.in[12], DM, FF2, Wup_t, a.in[11], 2, scr, 2 * (r / 22), (r % 22) * 8 + wave, lane_);
                else { r -= TR_UP; tr_pair<false>(a.in[15], FF, DM, Wdown_t, nullptr, 0, scr, 2 * (r >> 2), (r & 3) * 8 + wave, lane_); }
            }
        }
    }
    xcd_barrier(xbar); STAMP(3);

    if (PH_MASK & 8) inner_phase(lds, bid, G, Zb, crossF, crossB, a.in[6], a.in[4], a.in[5], MIX);
    xcd_barrier(xbar); STAMP(4);

    if (PH_MASK & 16) {
        pg8::Gemm g{MIX, Wout_t, T, DM, DM}; pg8::StaticOrder S; S.init(T, DM, G, bid);
        EpiRes<false> E{(const float*)XB, nullptr, X1, X1B, SSQ2};
        pg8::gemm_phase<EpiRes<false>, pg8::StaticOrder, true, true>(lds, g, S, E);
    }
    xcd_barrier(xbar); STAMP(5);

    if (PH_MASK & 32) {
        pg8::Gemm g{X1B, Wup_t, T, FF2, DM}; pg8::StaticOrder S; S.init(T, FF2, G, bid);
        EpiUp E{ACT, HALO, SSQ2, a.in[13], a.in[14], (LAS float*)(lds + EX_OFF)};
        pg8::gemm_phase<EpiUp, pg8::StaticOrder, true, true>(lds, g, S, E);
    }
    xcd_barrier(xbar); STAMP(6);

    if (PH_MASK & 64) {
        const float* cw = a.in[13]; const float* cb = a.in[14];
        for (int e = bid * 512 + tid; e < 128 * FF; e += G * 512) {
            const int idx = e / FF, c = e - idx * FF, p = idx >> 1, which = idx & 1;
            const int row = p * 256 + (which ? 255 : 0);
            const bool first = (row == 0) || (row == 4096) || (row == 8192), last = (row == 4095) || (row == 8191) || (row == 16383);
            const int pa = 256 * (c >> 7) + (c & 127), pb = pa + 128;
            const float* hp = HALO + (size_t)(p * 4) * FF2;
            float pra, prb, cua, cub, nxa, nxb;
            if (which == 0) {
                pra = first ? 0.f : hp[-(ptrdiff_t)FF2 + pa]; prb = first ? 0.f : hp[-(ptrdiff_t)FF2 + pb];
                cua = hp[pa]; cub = hp[pb]; nxa = hp[FF2 + pa]; nxb = hp[FF2 + pb];
            } else {
                pra = hp[2 * FF2 + pa]; prb = hp[2 * FF2 + pb]; cua = hp[3 * FF2 + pa]; cub = hp[3 * FF2 + pb];
                nxa = last ? 0.f : hp[4 * (size_t)FF2 + pa]; nxb = last ? 0.f : hp[4 * (size_t)FF2 + pb];
            }
            const float va = cw[c] * pra + cw[FF2 + c] * cua + cw[2 * FF2 + c] * nxa + cb[c];
            const float vb = cw[FF + c] * prb + cw[FF2 + FF + c] * cub + cw[2 * FF2 + FF + c] * nxb + cb[FF + c];
            ACT[(size_t)row * FF + c] = (bf16_t)(cvt_pk_bf16(silu_f(va) * vb, 0.f) & 0xffffu);
        }
    }
    xcd_barrier(xbar); STAMP(7);

    if (PH_MASK & 128) {
        pg8::Gemm g{ACT, Wdown_t, T, DM, FF}; pg8::StaticOrder S; S.init(T, DM, G, bid);
        EpiRes<true> E{nullptr, nullptr, (float*)X2B, X1B, SSQ3};
        pg8::gemm_phase<EpiRes<true>, pg8::StaticOrder, true, true>(lds, g, S, E);
    }
    xcd_barrier(xbar); STAMP(8);

    if (PH_MASK & 256) {
        const int gw = bid * 8 + wave, NGW = G * 8; const float* fw = a.in[16];
        for (int row = gw; row < T; row += NGW) {
            float s = lane < 32 ? SSQ3[(size_t)row * 32 + lane] : 0.f;
            s = wave_sum(s);
            const float rs = rsqrtf(s * (1.0f / DM) + EPS);
            float* orow = a.out + (size_t)row * DM; const bf16_t* xrow = X2B + (size_t)row * DM;
#pragma unroll
            for (int j = 0; j < 4; ++j) { const u32x4 xb = *(const u32x4*)(xrow + 512 * j + 8 * lane); const f32x4 w0 = *(const f32x4*)(fw + 512 * j + 8 * lane), w1 = *(const f32x4*)(fw + 512 * j + 8 * lane + 4);
                f32x4 o0, o1; o0[0] = bf_lo(xb.x) * rs * w0[0]; o0[1] = bf_hi(xb.x) * rs * w0[1]; o0[2] = bf_lo(xb.y) * rs * w0[2]; o0[3] = bf_hi(xb.y) * rs * w0[3];
                o1[0] = bf_lo(xb.z) * rs * w1[0]; o1[1] = bf_hi(xb.z) * rs * w1[1]; o1[2] = bf_lo(xb.w) * rs * w1[2]; o1[3] = bf_hi(xb.w) * rs * w1[3];
                *(f32x4*)(orow + 512 * j + 8 * lane) = o0; *(f32x4*)(orow + 512 * j + 8 * lane + 4) = o1; }
        }
    }
#if REP_MASK
    STAMP(9);
    if (blockIdx.x == 0 && threadIdx.x == 0) {
        volatile LAS unsigned* tsv = (volatile LAS unsigned*)(lds + MISC_OFF + 64);
        unsigned dt = 0;
#pragma unroll
        for (int k = 0; k < 9; ++k) if ((REP_MASK >> k) & 1) dt += tsv[k + 1] - tsv[k];
        const unsigned t0 = (unsigned)__builtin_amdgcn_s_memrealtime();
        while ((unsigned)__builtin_amdgcn_s_memrealtime() - t0 < dt) __builtin_amdgcn_s_sleep(8);
    }
#endif
}

extern "C" void kernel_launch(void* const* d_in, const int* in_sizes, int n_in, void* d_out, int out_size, void* d_ws, size_t ws_size, hipStream_t stream) {
    static int grid = 0;
    if (grid == 0) {
        if (n_in != 17 || out_size != 2 * T / 2 * DM || ws_size < WS_END) { fprintf(stderr, "kernel_launch: unexpected sizes n_in %d out %d ws %zu (need %zu)\n", n_in, out_size, ws_size, (size_t)WS_END); grid = -1; }
        else {
            int dev = 0, cus = 0, per_cu = 0;
            (void)hipGetDevice(&dev); (void)hipDeviceGetAttribute(&cus, hipDeviceAttributeMultiprocessorCount, dev);
            (void)hipFuncSetAttribute((const void*)fwd_kernel, hipFuncAttributeMaxDynamicSharedMemorySize, LDS_BYTES);
            (void)hipOccupancyMaxActiveBlocksPerMultiprocessor(&per_cu, (const void*)fwd_kernel, 512, LDS_BYTES);
            if (per_cu < 1 || cus < 1) { fprintf(stderr, "kernel_launch: occupancy query says %d blocks/CU on %d CUs\n", per_cu, cus); grid = -1; }
            else grid = cus;
        }
    }
    if (grid < 0) { (void)hipMemsetAsync(d_out, 0, (size_t)out_size * 4, stream); return; }
    (void)hipMemsetAsync((char*)d_ws + WS_CTL, 0, 65536, stream);
    Args a{};
    for (int i = 0; i < 17; ++i) a.in[i] = (const float*)d_in[i];
    a.out = (float*)d_out; a.ws = (unsigned char*)d_ws;
    void* kargs[] = {&a};
    const hipError_t e = hipLaunchCooperativeKernel((const void*)fwd_kernel, dim3(grid), dim3(512), kargs, LDS_BYTES, stream);
    if (e != hipSuccess) fprintf(stderr, "kernel_launch: cooperative launch failed: %s (grid %d)\n", hipGetErrorString(e), grid);
}
```

```cpp
#include <hip/hip_runtime.h>
#include <hip/hip_cooperative_groups.h>
#include <cstdio>
#include <cstdint>
namespace cg = cooperative_groups;
namespace pg8 {
#define PG8_LAS __attribute__((address_space(3)))
typedef unsigned short bf16_t;
typedef short bf16x8 __attribute__((ext_vector_type(8)));
typedef float f32x4 __attribute__((ext_vector_type(4)));
typedef unsigned u32x4 __attribute__((ext_vector_type(4)));
constexpr int BM = 256, BK = 64, HALF = 128, HTB = HALF * BK * 2  , STAGE_BYTES = 8 * HTB, NXCD = 8, WGM = 8;

__host__ __device__ __forceinline__ int lds_byte(int r, int c) { const int st = (r >> 4) * 2 + (c >> 5), rr = r & 15, cc = c & 31, ob = rr * 64 + cc * 2; return st * 1024 + (ob ^ (((ob >> 9) & 1) << 5)); }
__host__ __device__ __forceinline__ void stage_rc(int b, int& R, int& C) { const int st = b / 1024, sb = b % 1024, swz = sb ^ (((sb >> 9) & 1) << 5); R = (st >> 1) * 16 + swz / 64; C = (st & 1) * 32 + (swz % 64) / 2; }
__host__ __device__ __forceinline__ int perm32(int rho) { const int n = rho >> 4, i = rho & 15; return 8 * (i >> 2) + 4 * n + (i & 3); }

struct Unit { int pm, pn; };
struct Gemm { const bf16_t* A; const bf16_t* Bt; int M, N, K; };

struct StaticOrder {
    int nM, nN, nwg, G, c;
    __host__ __device__ void init(int M, int N, int G_, int c_) { nM = M / BM; nN = N / BM; nwg = nM * nN; G = G_; c = c_; }
    __host__ __device__ bool next(int i, Unit& u) const {
        const long L = (long)i * G + c; if (L >= nwg) return false;
        int wgid = (int)L; { const int q = nwg / NXCD, r = nwg % NXCD, xcd = wgid % NXCD, off = wgid / NXCD; wgid = (xcd < r ? xcd * (q + 1) : r * (q + 1) + (xcd - r) * q) + off; }
        const int nig = WGM * nN, gid = wgid / nig, fm = gid * WGM, gsz = (nM - fm) < WGM ? (nM - fm) : WGM;
        u.pm = fm + ((wgid % nig) % gsz); u.pn = (wgid % nig) / gsz; return true;
    }
    __device__ __forceinline__ void a_ready(const Unit&) const {}
    __device__ __forceinline__ void done(const Unit&) const {}
};

__device__ __forceinline__ unsigned cvt_pk_bf16(float lo, float hi) { unsigned r; asm volatile("v_cvt_pk_bf16_f32 %0, %1, %2" : "=v"(r) : "v"(lo), "v"(hi)); return r; }
template <class Epi, class Sched, bool ALIGN_EPI = false, bool SP2 = false>
__device__ __forceinline__ void gemm_phase(PG8_LAS unsigned char* lds, const Gemm g, const Sched& S, const Epi& E) {
    int tid_ = threadIdx.x; asm volatile("" : "+v"(tid_));
    const int tid = tid_, wid = __builtin_amdgcn_readfirstlane(tid >> 6), lane = tid & 63, wr = wid >> 2, wc = wid & 3, fr = lane & 15, fq = lane >> 4;
    const int K = g.K, nt = K / BK;
    unsigned voffA[2], voffB[2];
#pragma unroll
    for (int i = 0; i < 2; ++i) { int R, C; stage_rc(tid * 16 + i * 8192, R, C); const int Rb = Epi::PERM ? ((R & ~31) + perm32(R & 31)) : R;
        const int Ra = Epi::PERMA ? ((R & 64) + 4 * (R & 15) + ((R >> 4) & 3)) : R; voffA[i] = (unsigned)(Ra * K + C) * 2u; voffB[i] = (unsigned)(Rb * K + C) * 2u; }
    const size_t kstep = (size_t)(BK * 2);
    const size_t hstep = (size_t)HALF * K * 2;
    const size_t tstep = 2 * hstep;
    const unsigned ldsw = (unsigned)wid * 1024u;
    const int aoff = lds_byte(wr * 64 + fr, fq * 8), boff = lds_byte(wc * 32 + fr, fq * 8);
#define PG8_SA(b, h) (((b) * 2 + (h)) * HTB)
#define PG8_SB(b, h) ((4 + (b) * 2 + (h)) * HTB)
#define PG8_STAGE(bufoff, gbase, voff) do { _Pragma("unroll") for (int _i = 0; _i < 2; ++_i) \
        __builtin_amdgcn_global_load_lds((const unsigned*)((const char*)(gbase) + (voff)[_i]), (PG8_LAS unsigned*)(lds + (bufoff) + ldsw + _i * 8192), 16, 0, 0); } while (0)
#define PG8_LDA(dst, b, h) do { _Pragma("unroll") for (int m = 0; m < 4; ++m) _Pragma("unroll") for (int k = 0; k < 2; ++k) dst[m][k] = *(const PG8_LAS bf16x8*)(lds + PG8_SA(b, h) + aoff + m * 2048 + k * 1024); } while (0)
#define PG8_LDB(dst, b, h) do { _Pragma("unroll") for (int n = 0; n < 2; ++n) _Pragma("unroll") for (int k = 0; k < 2; ++k) dst[n][k] = *(const PG8_LAS bf16x8*)(lds + PG8_SB(b, h) + boff + n * 2048 + k * 1024); } while (0)
#define PG8_MMA(ai, bj, At, Bt) do { __builtin_amdgcn_s_setprio(1); _Pragma("unroll") for (int m = 0; m < 4; ++m) _Pragma("unroll") for (int n = 0; n < 2; ++n) _Pragma("unroll") for (int k = 0; k < 2; ++k) \
        acc[ai][bj][m][n] = __builtin_amdgcn_mfma_f32_16x16x32_bf16(Bt[n][k], At[m][k], acc[ai][bj][m][n], 0, 0, 0); __builtin_amdgcn_s_setprio(0); } while (0)
#define PG8_WAIT_V(n) asm volatile("s_waitcnt vmcnt(" #n ")" ::: "memory")
#define PG8_WAIT_L(n) asm volatile("s_waitcnt lgkmcnt(" #n ")" ::: "memory")
#define PG8_BAR __builtin_amdgcn_s_barrier()
#define PG8_SCHED __builtin_amdgcn_sched_barrier(0)
    Unit cur, nxt; int ui = 0;
    if (!S.next(0, cur)) return;
    f32x4 acc[2][2][4][2];
#pragma unroll
    for (int a = 0; a < 2; ++a)
#pragma unroll
        for (int b = 0; b < 2; ++b)
#pragma unroll
            for (int m = 0; m < 4; ++m)
#pragma unroll
                for (int n = 0; n < 2; ++n) acc[a][b][m][n] = (f32x4){0.f, 0.f, 0.f, 0.f};
    bf16x8 At[4][2], B0[2][2], B1[2][2];
    const char* cA = (const char*)g.A + (size_t)cur.pm * tstep; const char* cB = (const char*)g.Bt + (size_t)cur.pn * tstep;
    S.a_ready(cur);
    if constexpr (SP2) {
        PG8_STAGE(PG8_SB(0, 0), cB, voffB); PG8_STAGE(PG8_SB(0, 1), cB + hstep, voffB); PG8_STAGE(PG8_SA(0, 0), cA, voffA); PG8_STAGE(PG8_SA(0, 1), cA + hstep, voffA);
        if (wr == 1) PG8_BAR;
        PG8_WAIT_V(2); PG8_BAR;
        PG8_STAGE(PG8_SB(1, 0), cB + kstep, voffB); PG8_STAGE(PG8_SA(1, 0), cA + kstep, voffA); PG8_STAGE(PG8_SB(1, 1), cB + hstep + kstep, voffB);
        PG8_WAIT_V(6); PG8_BAR;
    } else {
        PG8_STAGE(PG8_SB(0, 0), cB, voffB); PG8_STAGE(PG8_SA(0, 0), cA, voffA); PG8_STAGE(PG8_SB(0, 1), cB + hstep, voffB); PG8_STAGE(PG8_SA(0, 1), cA + hstep, voffA);
        if (wr == 1) PG8_BAR;
        PG8_WAIT_V(4); PG8_BAR;
        PG8_STAGE(PG8_SB(1, 0), cB + kstep, voffB); PG8_STAGE(PG8_SA(1, 0), cA + kstep, voffA); PG8_STAGE(PG8_SB(1, 1), cB + hstep + kstep, voffB);
        PG8_WAIT_V(6); PG8_BAR;
    }
    for (;;) {
        const bool has_next = S.next(ui + 1, nxt);
        const char* nA = has_next ? (const char*)g.A + (size_t)nxt.pm * tstep : cA; const char* nB = has_next ? (const char*)g.Bt + (size_t)nxt.pn * tstep : cB;
        for (int t = 0; t < nt; t += 2) {
            const bool last = (t == nt - 2);
            const char* a1 = cA + (size_t)(t + 1) * kstep;
            const char* a2 = last ? nA : cA + (size_t)(t + 2) * kstep; const char* b2 = last ? nB : cB + (size_t)(t + 2) * kstep;
            const char* a3 = a2 + kstep; const char* b3 = b2 + kstep;
            if (last && has_next) S.a_ready(nxt);
            if constexpr (SP2) {
            PG8_LDB(B0, 0, 0); PG8_LDB(B1, 0, 1); PG8_SCHED; PG8_LDA(At, 0, 0); PG8_STAGE(PG8_SA(1, 1), a1 + hstep, voffA);
            PG8_WAIT_V(8); PG8_WAIT_L(0); PG8_BAR; PG8_MMA(0, 0, At, B0); PG8_MMA(0, 1, At, B1); PG8_BAR; PG8_SCHED;
            PG8_LDA(At, 0, 1); PG8_STAGE(PG8_SB(0, 0), b2, voffB); PG8_STAGE(PG8_SB(0, 1), b2 + hstep, voffB); PG8_STAGE(PG8_SA(0, 0), a2, voffA);
            PG8_WAIT_V(8); PG8_WAIT_L(0); PG8_BAR; PG8_MMA(1, 0, At, B0); PG8_MMA(1, 1, At, B1); PG8_BAR; PG8_SCHED;
            PG8_LDB(B0, 1, 0); PG8_LDB(B1, 1, 1); PG8_SCHED; PG8_LDA(At, 1, 0); PG8_STAGE(PG8_SA(0, 1), a2 + hstep, voffA);
            PG8_WAIT_V(8); PG8_WAIT_L(0); PG8_BAR; PG8_MMA(0, 0, At, B0); PG8_MMA(0, 1, At, B1); PG8_BAR; PG8_SCHED;
            PG8_LDA(At, 1, 1); PG8_STAGE(PG8_SB(1, 0), b3, voffB); PG8_STAGE(PG8_SB(1, 1), b3 + hstep, voffB); PG8_STAGE(PG8_SA(1, 0), a3, voffA);
            PG8_WAIT_V(8); PG8_WAIT_L(0); PG8_BAR; PG8_MMA(1, 0, At, B0); PG8_MMA(1, 1, At, B1); PG8_BAR; PG8_SCHED;
            } else {
            PG8_LDB(B0, 0, 0); PG8_SCHED; PG8_LDA(At, 0, 0); PG8_STAGE(PG8_SA(1, 1), a1 + hstep, voffA);
            PG8_WAIT_L(8); PG8_BAR; PG8_WAIT_L(0); PG8_MMA(0, 0, At, B0); PG8_BAR; PG8_SCHED;
            PG8_LDB(B1, 0, 1); PG8_STAGE(PG8_SB(0, 0), b2, voffB);
            PG8_BAR; PG8_WAIT_L(0); PG8_MMA(0, 1, At, B1); PG8_BAR;
            PG8_LDA(At, 0, 1); PG8_STAGE(PG8_SA(0, 0), a2, voffA);
            PG8_BAR; PG8_WAIT_L(0); PG8_MMA(1, 0, At, B0); PG8_BAR; PG8_SCHED;
            PG8_STAGE(PG8_SB(0, 1), b2 + hstep, voffB);
            PG8_WAIT_V(6); PG8_BAR; PG8_MMA(1, 1, At, B1); PG8_BAR;
            PG8_LDB(B0, 1, 0); PG8_SCHED; PG8_LDA(At, 1, 0); PG8_STAGE(PG8_SA(0, 1), a2 + hstep, voffA);
            PG8_WAIT_L(8); PG8_BAR; PG8_WAIT_L(0); PG8_MMA(0, 0, At, B0); PG8_BAR; PG8_SCHED;
            PG8_LDB(B1, 1, 1); PG8_STAGE(PG8_SB(1, 0), b3, voffB);
            PG8_BAR; PG8_WAIT_L(0); PG8_MMA(0, 1, At, B1); PG8_BAR;
            PG8_LDA(At, 1, 1); PG8_STAGE(PG8_SA(1, 0), a3, voffA);
            PG8_BAR; PG8_WAIT_L(0); PG8_MMA(1, 0, At, B0); PG8_BAR; PG8_SCHED;
            PG8_STAGE(PG8_SB(1, 1), b3 + hstep, voffB);
            PG8_WAIT_V(6); PG8_BAR; PG8_MMA(1, 1, At, B1); PG8_BAR;
            }
        }
        if constexpr (ALIGN_EPI) { if (wr == 0) PG8_BAR; }
        if constexpr (!Epi::AFTER_DRAIN) { E(acc, cur, wr, wc, fr, fq); S.done(cur); }
        if (!has_next) break;
#pragma unroll
        for (int a = 0; a < 2; ++a)
#pragma unroll
            for (int b = 0; b < 2; ++b)
#pragma unroll
                for (int m = 0; m < 4; ++m)
#pragma unroll
                    for (int n = 0; n < 2; ++n) acc[a][b][m][n] = (f32x4){0.f, 0.f, 0.f, 0.f};
        cur = nxt; cA = nA; cB = nB; ++ui;
        if constexpr (ALIGN_EPI) { if (wr == 1) PG8_BAR; }
    }
    PG8_WAIT_V(0);
    if constexpr (!ALIGN_EPI) { if (wr == 0) PG8_BAR; }
    PG8_BAR;
    if constexpr (Epi::AFTER_DRAIN) { E.fused(acc, cur, wr, wc, fr, fq, lds, wid, lane); S.done(cur); }
#undef PG8_SA
#undef PG8_SB
#undef PG8_STAGE
#undef PG8_LDA
#undef PG8_LDB
#undef PG8_MMA
#undef PG8_WAIT_V
#undef PG8_WAIT_L
#undef PG8_BAR
#undef PG8_SCHED
}
}

#ifndef PH_MASK
#define PH_MASK 0x1ff
#endif
#ifndef REP_MASK
#define REP_MASK 0
#endif
#define DI __device__ __forceinline__
#define LAS __attribute__((address_space(3)))
using pg8::bf16_t; using pg8::bf16x8; using pg8::f32x4; using pg8::u32x4; using pg8::cvt_pk_bf16;
typedef unsigned u32x2 __attribute__((ext_vector_type(2)));

constexpr int T = 16384, DM = 2048, INC = 6144, FF = 5632, FF2 = 11264, RW = 1024;
constexpr float EPS = 1e-6f, LOG2E = 1.4426950408889634f;
constexpr size_t MiB = 1u << 20;
constexpr size_t WS_CTL = 0, WS_ROPE = 1 * MiB, WS_WOUT = 5 * MiB, WS_WUP = 13 * MiB, WS_WDOWN = 57 * MiB;
constexpr size_t WS_Z = 79 * MiB;
constexpr size_t WS_X1B = 79 * MiB;
constexpr size_t WS_ACT = 143 * MiB;
constexpr size_t WS_WIN = 271 * MiB;
constexpr size_t WS_MIX = 271 * MiB;
constexpr size_t WS_HALO = 319 * MiB;
constexpr size_t WS_RS1 = 336 * MiB, WS_SSQV = 337 * MiB, WS_SSQ2 = 338 * MiB, WS_SSQ3 = 340 * MiB, WS_END = 342 * MiB;
constexpr int RING_BYTES = 131072, EX_OFF = 131072, MISC_OFF = 139264, LDS_BYTES = 147456;
constexpr int TP = 136;
constexpr int TR_OUT = (DM / 128) * (DM / 512), TR_UP = (DM / 128) * (FF2 / 512), TR_DN = (FF / 128) * (DM / 512), TR_ITEMS = TR_OUT + TR_UP + TR_DN;

DI float silu_f(float x) { return x * __builtin_amdgcn_rcpf(1.f + __builtin_amdgcn_exp2f(-LOG2E * x)); }
DI float gelu_f(float x) { const float u = x + 0.044715f * x * x * x; return x * __builtin_amdgcn_rcpf(1.f + __builtin_amdgcn_exp2f(-2.f * 0.7978845608028654f * LOG2E * u)); }
DI f32x4 silu4(f32x4 x) { const f32x4 t = x * (-LOG2E); f32x4 e; e[0] = __builtin_amdgcn_exp2f(t[0]); e[1] = __builtin_amdgcn_exp2f(t[1]); e[2] = __builtin_amdgcn_exp2f(t[2]); e[3] = __builtin_amdgcn_exp2f(t[3]);
    const f32x4 d = e + 1.0f; f32x4 r; r[0] = __builtin_amdgcn_rcpf(d[0]); r[1] = __builtin_amdgcn_rcpf(d[1]); r[2] = __builtin_amdgcn_rcpf(d[2]); r[3] = __builtin_amdgcn_rcpf(d[3]); return x * r; }
DI f32x4 gelu4(f32x4 x) { const f32x4 u = x * (x * x * 0.044715f + 1.0f); const f32x4 t = u * (-2.f * 0.7978845608028654f * LOG2E);
    f32x4 e; e[0] = __builtin_amdgcn_exp2f(t[0]); e[1] = __builtin_amdgcn_exp2f(t[1]); e[2] = __builtin_amdgcn_exp2f(t[2]); e[3] = __builtin_amdgcn_exp2f(t[3]);
    const f32x4 d = e + 1.0f; f32x4 r; r[0] = __builtin_amdgcn_rcpf(d[0]); r[1] = __builtin_amdgcn_rcpf(d[1]); r[2] = __builtin_amdgcn_rcpf(d[2]); r[3] = __builtin_amdgcn_rcpf(d[3]); return x * r; }
DI float bf_lo(unsigned w) { return __uint_as_float(w << 16); }
DI float bf_hi(unsigned w) { return __uint_as_float(w & 0xffff0000u); }
DI unsigned short u16_of(const u32x4& v, int e) { const unsigned w = v[e >> 1]; return (unsigned short)((e & 1) ? (w >> 16) : (w & 0xffffu)); }
DI u32x2 pack4(const f32x4& v) { u32x2 r; r.x = cvt_pk_bf16(v[0], v[1]); r.y = cvt_pk_bf16(v[2], v[3]); return r; }
DI float sum4(const f32x4& v) { return (v[0] + v[1]) + (v[2] + v[3]); }
DI float sq4(const f32x4& v) { return (v[0] * v[0] + v[1] * v[1]) + (v[2] * v[2] + v[3] * v[3]); }
DI float wave_sum(float v) {
#pragma unroll
    for (int o = 1; o < 64; o <<= 1) v += __shfl_xor(v, o);
    return v;
}
#define LBAR() do { asm volatile("s_waitcnt lgkmcnt(0)" ::: "memory"); __builtin_amdgcn_s_barrier(); asm volatile("" ::: "memory"); } while (0)
#define MFMA16(a, b, c) __builtin_amdgcn_mfma_f32_16x16x32_bf16((a), (b), (c), 0, 0, 0)

struct EpiIn {
    static constexpr bool PERM = true, AFTER_DRAIN = false, PERMA = false;
    bf16_t* Z; const float* rs1; const float* rope; float* ssqv;
    DI void operator()(const f32x4 (&acc)[2][2][4][2], const pg8::Unit& u, int wr, int wc, int fr, int fq) const {
        const int region = u.pn >> 2;
#pragma unroll
        for (int ai = 0; ai < 2; ++ai)
#pragma unroll
            for (int m = 0; m < 4; ++m) {
                const int row = u.pm * 256 + ai * 128 + wr * 64 + m * 16 + fr;
                const float rs = rs1[row];
                bf16_t* zr = Z + (size_t)row * INC;
                if (region < 2) {
                    const int pos = row < 4096 ? row : (row < 8192 ? row - 4096 : row - 8192);
                    const f32x4* rp = (const f32x4*)(rope + ((size_t)pos * 64 + 16 * wc + 4 * fq) * 2);
                    const f32x4 cs0 = rp[0], cs1 = rp[1];
#pragma unroll
                    for (int bj = 0; bj < 2; ++bj) {
                        const f32x4 x1 = acc[ai][bj][m][0] * rs, x2 = acc[ai][bj][m][1] * rs;
                        f32x4 o1, o2;
                        o1[0] = x1[0] * cs0[0] - x2[0] * cs0[1]; o2[0] = x2[0] * cs0[0] + x1[0] * cs0[1];
                        o1[1] = x1[1] * cs0[2] - x2[1] * cs0[3]; o2[1] = x2[1] * cs0[2] + x1[1] * cs0[3];
                        o1[2] = x1[2] * cs1[0] - x2[2] * cs1[1]; o2[2] = x2[2] * cs1[0] + x1[2] * cs1[1];
                        o1[3] = x1[3] * cs1[2] - x2[3] * cs1[3]; o2[3] = x2[3] * cs1[2] + x1[3] * cs1[3];
                        const int col = region * 1024 + ((u.pn & 3) * 2 + bj) * 128 + 16 * wc + 4 * fq;
                        *(u32x2*)(zr + col) = pack4(o1); *(u32x2*)(zr + col + 64) = pack4(o2);
                    }
                } else {
                    float ss = 0.f;
#pragma unroll
                    for (int bj = 0; bj < 2; ++bj) {
                        f32x4 v0 = acc[ai][bj][m][0] * rs, v1 = acc[ai][bj][m][1] * rs;
                        if (region == 3) { v0 = silu4(v0); v1 = silu4(v1); }
                        else if (region >= 4) { v0 = gelu4(v0); v1 = gelu4(v1); }
                        ss += sq4(v0) + sq4(v1);
                        u32x4 w4; w4.x = cvt_pk_bf16(v0[0], v0[1]); w4.y = cvt_pk_bf16(v0[2], v0[3]); w4.z = cvt_pk_bf16(v1[0], v1[1]); w4.w = cvt_pk_bf16(v1[2], v1[3]);
                        *(u32x4*)(zr + u.pn * 256 + bj * 128 + 32 * wc + 8 * fq) = w4;
                    }
                    if (region == 5) { ss += __shfl_xor(ss, 16); ss += __shfl_xor(ss, 32); if (fq == 0) ssqv[(size_t)row * 16 + (u.pn - 20) * 4 + wc] = ss; }
                }
            }
    }
};

template <bool DOWN> struct EpiRes {
    static constexpr bool PERM = true, AFTER_DRAIN = false, PERMA = false;
    const float* xp; const float* xs; float* X1; bf16_t* X1B; float* ssq;
    DI void operator()(const f32x4 (&acc)[2][2][4][2], const pg8::Unit& u, int wr, int wc, int fr, int fq) const {
#pragma unroll
        for (int ai = 0; ai < 2; ++ai)
#pragma unroll
            for (int m = 0; m < 4; ++m) {
                const int row = u.pm * 256 + ai * 128 + wr * 64 + m * 16 + fr;
                float ss = 0.f;
#pragma unroll
                for (int bj = 0; bj < 2; ++bj) {
                    const int col = u.pn * 256 + bj * 128 + 32 * wc + 8 * fq;
                    f32x4 b0, b1;
                    if (DOWN) { const u32x4 xb = *(const u32x4*)(X1B + (size_t)row * DM + col); b0[0] = bf_lo(xb.x); b0[1] = bf_hi(xb.x); b0[2] = bf_lo(xb.y); b0[3] = bf_hi(xb.y); b1[0] = bf_lo(xb.z); b1[1] = bf_hi(xb.z); b1[2] = bf_lo(xb.w); b1[3] = bf_hi(xb.w); }
                    else { const u32x4 xb = *(const u32x4*)((const bf16_t*)xp + (size_t)row * DM + col); b0[0] = bf_lo(xb.x); b0[1] = bf_hi(xb.x); b0[2] = bf_lo(xb.y); b0[3] = bf_hi(xb.y); b1[0] = bf_lo(xb.z); b1[1] = bf_hi(xb.z); b1[2] = bf_lo(xb.w); b1[3] = bf_hi(xb.w); }
                    const f32x4 v0 = acc[ai][bj][m][0] + b0, v1 = acc[ai][bj][m][1] + b1;
                    ss += sq4(v0) + sq4(v1);
                    if (DOWN) { u32x4 w4; w4.x = cvt_pk_bf16(v0[0], v0[1]); w4.y = cvt_pk_bf16(v0[2], v0[3]); w4.z = cvt_pk_bf16(v1[0], v1[1]); w4.w = cvt_pk_bf16(v1[2], v1[3]);
                        *(u32x4*)((bf16_t*)X1 + (size_t)row * DM + col) = w4; }
                    if (!DOWN) { u32x4 w4; w4.x = cvt_pk_bf16(v0[0], v0[1]); w4.y = cvt_pk_bf16(v0[2], v0[3]); w4.z = cvt_pk_bf16(v1[0], v1[1]); w4.w = cvt_pk_bf16(v1[2], v1[3]);
                        *(u32x4*)(X1B + (size_t)row * DM + col) = w4; }
                }
                ss += __shfl_xor(ss, 16); ss += __shfl_xor(ss, 32);
                if (fq == 0) ssq[(size_t)row * 32 + u.pn * 4 + wc] = ss;
            }
    }
};

struct EpiUp {
    static constexpr bool PERM = true, AFTER_DRAIN = false, PERMA = true;
    bf16_t* ACT; float* HALO; const float* ssq2; const float* convw; const float* convb; LAS float* ex;
    DI void operator()(const f32x4 (&acc)[2][2][4][2], const pg8::Unit& u, int wr, int wc, int fr, int fq) const {
        asm volatile("" : "+v"(fr), "+v"(fq));
        asm volatile("" : "+s"(wr), "+s"(wc));
        const int lane = fq * 16 + fr;
        const int tcol = 32 * wc + 8 * fq;
        float rs[2][4];
#pragma unroll
        for (int ai = 0; ai < 2; ++ai) {
#pragma unroll
            for (int m = 0; m < 4; ++m) {
                const int row = u.pm * 256 + ai * 128 + wr * 64 + 4 * fr + m;
                const f32x4* p = (const f32x4*)(ssq2 + (size_t)row * 32 + fq * 8);
                float s = sum4(p[0]) + sum4(p[1]);
                s += __shfl_xor(s, 16); s += __shfl_xor(s, 32);
                rs[ai][m] = rsqrtf(s * (1.0f / DM) + EPS);
            }
            const int b = 2 * ai + wr;
            if (fr == 0 || fr == 15) {
                const bool lo = fr == 0;
#pragma unroll
                for (int bj = 0; bj < 2; ++bj)
#pragma unroll
                    for (int n = 0; n < 2; ++n) {
                        const f32x4 a0 = acc[ai][bj][0][n] * rs[ai][0], a3 = acc[ai][bj][3][n] * rs[ai][3];
                        f32x4 val; val[0] = lo ? a0[0] : a3[0]; val[1] = lo ? a0[1] : a3[1]; val[2] = lo ? a0[2] : a3[2]; val[3] = lo ? a0[3] : a3[3];
                        *(LAS f32x4*)(ex + (b * 2 + (lo ? 0 : 1)) * 256 + bj * 128 + tcol + 4 * n) = val;
                    }
            }
        }
        {
            const bool hfirst = (wr == 0 && fr == 0), hlast = (wr == 1 && fr == 15);
            if (hfirst || hlast) {
#pragma unroll
                for (int k = 0; k < 2; ++k)
#pragma unroll
                    for (int bj = 0; bj < 2; ++bj)
#pragma unroll
                        for (int n = 0; n < 2; ++n) {
                            const f32x4 a0 = acc[0][bj][k][n] * rs[0][k], a1 = acc[1][bj][2 + k][n] * rs[1][2 + k];
                            f32x4 val; val[0] = hfirst ? a0[0] : a1[0]; val[1] = hfirst ? a0[1] : a1[1]; val[2] = hfirst ? a0[2] : a1[2]; val[3] = hfirst ? a0[3] : a1[3];
                            *(f32x4*)(HALO + (size_t)(u.pm * 4 + (hfirst ? k : 2 + k)) * FF2 + u.pn * 256 + bj * 128 + tcol + 4 * n) = val;
                        }
            }
        }
        LBAR();
        const int src_dn = (lane & 48) | ((fr + 15) & 15), src_up = (lane & 48) | ((fr + 1) & 15);
#pragma unroll
        for (int n = 0; n < 2; ++n) {
            const int ca = u.pn * 128 + tcol + 4 * n;
            f32x4 cw[2][4];
#pragma unroll
            for (int bj = 0; bj < 2; ++bj) { cw[bj][0] = *(const f32x4*)(convw + ca + bj * FF); cw[bj][1] = *(const f32x4*)(convw + FF2 + ca + bj * FF); cw[bj][2] = *(const f32x4*)(convw + 2 * FF2 + ca + bj * FF); cw[bj][3] = *(const f32x4*)(convb + ca + bj * FF); }
#pragma unroll
            for (int ai = 0; ai < 2; ++ai) {
                const int b = 2 * ai + wr;
                f32x4 cva[4], outv[4];
#pragma unroll
                for (int bj = 0; bj < 2; ++bj) {
                    f32x4 v[4];
#pragma unroll
                    for (int m = 0; m < 4; ++m) v[m] = acc[ai][bj][m][n] * rs[ai][m];
                    f32x4 prevv, nextv;
#pragma unroll
                    for (int i = 0; i < 4; ++i) {
                        prevv[i] = __uint_as_float((unsigned)__builtin_amdgcn_update_dpp(0, (int)__float_as_uint(v[3][i]), 0x111, 0xf, 0xf, false));
                        nextv[i] = __uint_as_float((unsigned)__builtin_amdgcn_update_dpp(0, (int)__float_as_uint(v[0][i]), 0x101, 0xf, 0xf, false));
                    }
                    if (fr == 0) prevv = *(const LAS f32x4*)(ex + (((b > 0 ? b - 1 : 0)) * 2 + 1) * 256 + bj * 128 + tcol + 4 * n);
                    if (fr == 15) nextv = *(const LAS f32x4*)(ex + (((b < 3 ? b + 1 : 3)) * 2 + 0) * 256 + bj * 128 + tcol + 4 * n);
#pragma unroll
                    for (int m = 0; m < 4; ++m) {
                        const f32x4 pv = m == 0 ? prevv : v[m > 0 ? m - 1 : 0], nv = m == 3 ? nextv : v[m < 3 ? m + 1 : 3];
                        const f32x4 cv = cw[bj][0] * pv + cw[bj][1] * v[m] + cw[bj][2] * nv + cw[bj][3];
                        if (bj == 0) cva[m] = cv;
                        else {
                            outv[m] = silu4(cva[m]) * cv;
                        }
                    }
                }
#pragma unroll
                for (int m = 0; m < 4; ++m) {
                    const int tr = ai * 128 + wr * 64 + 4 * fr + m;
                    if (tr != 0 && tr != 255) *(u32x2*)(ACT + (size_t)(u.pm * 256 + tr) * FF + ca) = pack4(outv[m]);
                }
                __builtin_amdgcn_sched_barrier(0);
            }
        }
    }
};

DI void tr_load(f32x4 (&v)[16], const float* W, int N, int kb, int nb, int lane) {
    const int k0 = 64 * kb, n0 = 64 * nb;
#pragma unroll
    for (int i = 0; i < 16; ++i) v[i] = *(const f32x4*)(W + (size_t)(k0 + 4 * i + (lane >> 4)) * N + n0 + 4 * (lane & 15));
}
template <bool SCALE> DI void tr_finish(const f32x4 (&v)[16], const float (&ks)[16], int K, bf16_t* WT, int mode, LAS float* scr, int kb, int nb, int lane) {
    const int k0 = 64 * kb, n0 = 64 * nb;
#pragma unroll
    for (int i = 0; i < 16; ++i) { const int kk = 4 * i + (lane >> 4); *(LAS f32x4*)(scr + kk * 68 + 4 * (lane & 15)) = SCALE ? v[i] * ks[i] : v[i]; }
    asm volatile("s_waitcnt lgkmcnt(0)" ::: "memory");
    const int ncol = n0 + lane;
    int prow = ncol; float sc = 1.f;
    if (mode == 1) { const int region = ncol >> 10; if (region < 2) { const int cc = ncol & 127; prow = (ncol & ~127) + 32 * ((cc >> 4) & 3) + 8 * ((cc >> 2) & 3) + 4 * (cc >> 6) + (cc & 3); if (region == 0) sc = 0.08838834764831845f; } }
    else if (mode == 2) { if (ncol < FF) prow = 256 * (ncol >> 7) + (ncol & 127); else { const int nn = ncol - FF; prow = 256 * (nn >> 7) + 128 + (nn & 127); } }
    bf16_t* orow = WT + (size_t)prow * K + k0;
#pragma unroll
    for (int j = 0; j < 8; ++j) {
        const LAS float* sp = scr + (8 * j) * 68 + lane;
        u32x4 o; o.x = cvt_pk_bf16(sp[0 * 68] * sc, sp[1 * 68] * sc); o.y = cvt_pk_bf16(sp[2 * 68] * sc, sp[3 * 68] * sc); o.z = cvt_pk_bf16(sp[4 * 68] * sc, sp[5 * 68] * sc); o.w = cvt_pk_bf16(sp[6 * 68] * sc, sp[7 * 68] * sc);
        *(u32x4*)(orow + 8 * j) = o;
    }
    asm volatile("s_waitcnt lgkmcnt(0)" ::: "memory");
}
template <bool SCALE> DI void tr_pair(const float* W, int K, int N, bf16_t* WT, const float* kscale, int mode, LAS float* scr, int kb0, int nb, int lane) {
    float ksa[16], ksb[16];
#pragma unroll
    for (int i = 0; i < 16; ++i) { ksa[i] = SCALE ? kscale[64 * kb0 + 4 * i + (lane >> 4)] : 1.f; ksb[i] = SCALE ? kscale[64 * kb0 + 64 + 4 * i + (lane >> 4)] : 1.f; }
    f32x4 va[16], vb[16];
    tr_load(va, W, N, kb0, nb, lane); tr_load(vb, W, N, kb0 + 1, nb, lane);
    tr_finish<SCALE>(va, ksa, K, WT, mode, scr, kb0, nb, lane);
    tr_finish<SCALE>(vb, ksb, K, WT, mode, scr, kb0 + 1, nb, lane);
}

typedef short s16x4 __attribute__((ext_vector_type(4)));
DI bf16x8 tr_frag(const LAS bf16_t* tile, int pitch, int tok0, int f0, int lane) {
    const int i = lane & 15, q = i >> 2, p = i & 3, fq = lane >> 4;
    LAS bf16_t* a = (LAS bf16_t*)tile + (tok0 + 8 * fq + q) * pitch + f0 + 4 * p;
    const s16x4 lo = __builtin_amdgcn_ds_read_tr16_b64_v4i16((LAS s16x4*)a);
    const s16x4 hi = __builtin_amdgcn_ds_read_tr16_b64_v4i16((LAS s16x4*)(a + 4 * pitch));
    return __builtin_shufflevector(lo, hi, 0, 1, 2, 3, 4, 5, 6, 7);
}
constexpr int VP = 40;

DI void scan_item(LAS unsigned char* lds, int item, const bf16_t* Z, bf16_t* crossF, bf16_t* crossB, const float* lgf, const float* lgb) {
    const int tid = threadIdx.x, lane = tid & 63, w = tid >> 6, fr = lane & 15, fq = lane >> 4;
    const int sidx = item >> 6, rem = item & 63, h = rem >> 3, dir = (rem >> 2) & 1, sl = rem & 3;
    const int rowbase = sidx == 0 ? 8192 : (sidx == 1 ? 0 : 4096), nch = sidx == 0 ? 64 : 32;
    const float l2g = (dir ? lgb[h] : lgf[h]) * LOG2E;
    const float decay = exp2f(l2g * 128.f);
    bf16_t* cross = dir ? crossB : crossF;
    LAS bf16_t* Qn = (LAS bf16_t*)lds; LAS bf16_t* Kn = Qn + 128 * TP; LAS bf16_t* Vn = Kn + 128 * TP; LAS bf16_t* Rt = Vn + 128 * VP;
    f32x4 racc[2]; racc[0] = (f32x4){0.f, 0.f, 0.f, 0.f}; racc[1] = racc[0];
    const int vr = tid >> 2, vc = tid & 3;
    const float zeta = exp2f(l2g * (float)(dir ? vr : 127 - vr));
    const int n = 16 * w + fr;
    const float xi = exp2f(l2g * (float)(dir ? 128 - n : n + 1));
    const bf16_t* zbase = Z + (size_t)rowbase * INC + h * 128;
    u32x4 qA[4], kA[4], vA, qB[4], kB[4], vB, qC[4], kC[4], vC, qD[4], kD[4], vD;
#define SC_LOAD(Q_, K_, V_, s_) do { const int c_ = dir ? nch - 1 - (s_) : (s_); const bf16_t* zb = zbase + (size_t)c_ * 128 * INC; \
        _Pragma("unroll") for (int i = 0; i < 4; ++i) { const int v = tid + 512 * i; Q_[i] = *(const u32x4*)(zb + (size_t)(v >> 4) * INC + (v & 15) * 8); K_[i] = *(const u32x4*)(zb + (size_t)(v >> 4) * INC + 1024 + (v & 15) * 8); } \
        V_ = *(const u32x4*)(zb + (size_t)vr * INC + 2048 + sl * 32 + vc * 8); } while (0)
#define SC_STEP(Q_, K_, V_, s_) do { const int c_ = dir ? nch - 1 - (s_) : (s_); const int row0 = rowbase + c_ * 128; \
        _Pragma("unroll") for (int i = 0; i < 4; ++i) { const int v = tid + 512 * i; *(LAS u32x4*)(Qn + (v >> 4) * TP + (v & 15) * 8) = Q_[i]; *(LAS u32x4*)(Kn + (v >> 4) * TP + (v & 15) * 8) = K_[i]; } \
        { u32x4 o; _Pragma("unroll") for (int e = 0; e < 4; ++e) o[e] = cvt_pk_bf16(bf_lo(V_[e]) * zeta, bf_hi(V_[e]) * zeta); *(LAS u32x4*)(Vn + vr * VP + vc * 8) = o; } \
        _Pragma("unroll") for (int t = 0; t < 2; ++t) *(LAS u32x2*)(Rt + (16 * t + fr) * TP + 16 * w + 4 * fq) = pack4(racc[t]); \
        LBAR(); \
        if ((s_) + 4 < nch) SC_LOAD(Q_, K_, V_, (s_) + 4); \
        bf16x8 qf[4]; \
        _Pragma("unroll") for (int ks = 0; ks < 4; ++ks) qf[ks] = *(const LAS bf16x8*)(Qn + n * TP + ks * 32 + fq * 8); \
        _Pragma("unroll") for (int t = 0; t < 2; ++t) { f32x4 ca = {0.f, 0.f, 0.f, 0.f}; \
            _Pragma("unroll") for (int ks = 0; ks < 4; ++ks) { const bf16x8 rf = *(const LAS bf16x8*)(Rt + (16 * t + fr) * TP + ks * 32 + fq * 8); ca = MFMA16(rf, qf[ks], ca); } \
            *(u32x2*)(cross + (size_t)(row0 + n) * RW + h * 128 + sl * 32 + 16 * t + 4 * fq) = pack4(ca * xi); } \
        racc[0] = racc[0] * decay; racc[1] = racc[1] * decay; \
        _Pragma("unroll") for (int ks = 0; ks < 4; ++ks) { const bf16x8 kf = tr_frag(Kn, TP, 32 * ks, 16 * w, lane); \
            _Pragma("unroll") for (int t = 0; t < 2; ++t) { const bf16x8 vf = tr_frag(Vn, VP, 32 * ks, 16 * t, lane); racc[t] = MFMA16(kf, vf, racc[t]); } } \
        LBAR(); } while (0)
    SC_LOAD(qA, kA, vA, 0); SC_LOAD(qB, kB, vB, 1); SC_LOAD(qC, kC, vC, 2); SC_LOAD(qD, kD, vD, 3);
    for (int step = 0; step < nch; step += 4) { SC_STEP(qA, kA, vA, step); SC_STEP(qB, kB, vB, step + 1); SC_STEP(qC, kC, vC, step + 2); SC_STEP(qD, kD, vD, step + 3); }
#undef SC_LOAD
#undef SC_STEP
}

DI void sgu_item(LAS unsigned char* lds, int item, const bf16_t* Z, const float* ssqv, const float* normw, const bf16_t* wsb, const float* sgub, bf16_t* MIX) {
    const int tid = threadIdx.x, lane = tid & 63, w = tid >> 6, fr = lane & 15, fq = lane >> 4;
    const int chunk = item >> 3, g = item & 7, row0 = chunk * 128;
    LAS bf16_t* Wsl = (LAS bf16_t*)lds; LAS bf16_t* vt = Wsl + 128 * TP;
    const int tr = tid & 127, tc = tid >> 7;
    u32x4 wv[4], zv[4]; f32x4 nw[4][2];
#pragma unroll
    for (int i = 0; i < 4; ++i) { const int v = tid + 512 * i; wv[i] = *(const u32x4*)(wsb + (size_t)g * 16384 + (size_t)v * 8); }
#pragma unroll
    for (int i = 0; i < 4; ++i) { const int c8 = tc + 4 * i; zv[i] = *(const u32x4*)(Z + (size_t)(row0 + tr) * INC + 5 * 1024 + g * 128 + c8 * 8);
        nw[i][0] = *(const f32x4*)(normw + g * 128 + c8 * 8); nw[i][1] = *(const f32x4*)(normw + g * 128 + c8 * 8 + 4); }
    const f32x4* sp = (const f32x4*)(ssqv + (size_t)(row0 + tr) * 16);
    const float ss = sum4(sp[0]) + sum4(sp[1]) + sum4(sp[2]) + sum4(sp[3]);
    const int n = 16 * w + fr, row = row0 + n;
    const float bn = sgub[g * 128 + n];
    u32x2 uu[8];
#pragma unroll
    for (int db = 0; db < 8; ++db) uu[db] = *(const u32x2*)(Z + (size_t)row * INC + 4 * 1024 + g * 128 + 16 * db + 4 * fq);
    const float rsv = rsqrtf(ss * (1.0f / 1024.f) + EPS);
#pragma unroll
    for (int i = 0; i < 4; ++i) { const int v = tid + 512 * i; *(LAS u32x4*)(Wsl + (v >> 4) * TP + (v & 15) * 8) = wv[i]; }
#pragma unroll
    for (int i = 0; i < 4; ++i) {
        const int c8 = tc + 4 * i;
#pragma unroll
        for (int e = 0; e < 8; e += 2) {
            const unsigned wd = zv[i][e >> 1]; const float s0 = nw[i][e >> 2][e & 3] * rsv, s1 = nw[i][e >> 2][(e + 1) & 3] * rsv;
            const unsigned pk = cvt_pk_bf16(bf_lo(wd) * s0, bf_hi(wd) * s1);
            vt[(c8 * 8 + e) * TP + tr] = (unsigned short)(pk & 0xffffu); vt[(c8 * 8 + e + 1) * TP + tr] = (unsigned short)(pk >> 16);
        }
    }
    LBAR();
    bf16x8 wf[4];
#pragma unroll
    for (int ks = 0; ks < 4; ++ks) wf[ks] = *(const LAS bf16x8*)(Wsl + n * TP + ks * 32 + fq * 8);
#pragma unroll
    for (int db = 0; db < 8; ++db) {
        f32x4 s = {0.f, 0.f, 0.f, 0.f};
#pragma unroll
        for (int ks = 0; ks < 4; ++ks) { const bf16x8 vf = *(const LAS bf16x8*)(vt + (16 * db + fr) * TP + ks * 32 + fq * 8); s = MFMA16(vf, wf[ks], s); }
        const int col = g * 128 + 16 * db + 4 * fq;
        f32x4 o; o[0] = bf_lo(uu[db].x) * (s[0] + bn); o[1] = bf_hi(uu[db].x) * (s[1] + bn); o[2] = bf_lo(uu[db].y) * (s[2] + bn); o[3] = bf_hi(uu[db].y) * (s[3] + bn);
        *(u32x2*)(MIX + (size_t)row * DM + 1024 + col) = pack4(o);
    }
    LBAR();
}

DI void inner_phase(LAS unsigned char* lds, int bid, int G, const bf16_t* Z, const bf16_t* crossF, const bf16_t* crossB, const float* gnw, const float* lgf, const float* lgb, bf16_t* MIX) {
    const int tid = threadIdx.x, lane = tid & 63, w = tid >> 6, fr = lane & 15, fq = lane >> 4;
    LAS bf16_t* Qs = (LAS bf16_t*)lds; LAS bf16_t* Ks = Qs + 128 * TP; LAS bf16_t* Vt = Ks + 128 * TP;
    const int tr = tid & 127, tc = tid >> 7;
    u32x4 qr[4], kr[4], vr[4];
#define IN_LOAD(it_) do { const bf16_t* zb = Z + (size_t)((it_) >> 3) * 128 * INC + ((it_) & 7) * 128; \
        _Pragma("unroll") for (int i = 0; i < 4; ++i) { const int v = tid + 512 * i; const bf16_t* zp = zb + (size_t)(v >> 4) * INC + (v & 15) * 8; qr[i] = *(const u32x4*)zp; kr[i] = *(const u32x4*)(zp + 1024); \
            vr[i] = *(const u32x4*)(zb + (size_t)tr * INC + 2048 + (tc + 4 * i) * 8); } } while (0)
    if (bid < 1024) IN_LOAD(bid);
    for (int item = bid; item < 1024; item += G) {
        const int chunk = item >> 3, h = item & 7, row0 = chunk * 128;
#pragma unroll
        for (int i = 0; i < 4; ++i) { const int v = tid + 512 * i; const int o = (v >> 4) * TP + (v & 15) * 8; *(LAS u32x4*)(Qs + o) = qr[i]; *(LAS u32x4*)(Ks + o) = kr[i];
#pragma unroll
            for (int e = 0; e < 8; ++e) { const int c8 = tc + 4 * i; Vt[(32 * (c8 >> 2) + 16 * (e >> 2) + 4 * (c8 & 3) + (e & 3)) * TP + tr] = u16_of(vr[i], e); } }
        LBAR();
        const float l2f = lgf[h] * LOG2E, l2b = lgb[h] * LOG2E;
        const int n = 16 * w + fr, row = row0 + n;
        u32x4 cf[4], cb[4], gg[4];
#pragma unroll
        for (int a4 = 0; a4 < 4; ++a4) { const int col = h * 128 + 32 * a4 + 8 * fq; cf[a4] = *(const u32x4*)(crossF + (size_t)row * RW + col); cb[a4] = *(const u32x4*)(crossB + (size_t)row * RW + col);
            gg[a4] = *(const u32x4*)(Z + (size_t)row * INC + 3 * 1024 + col); }
        asm volatile("" ::: "memory");
        if (item + G < 1024) IN_LOAD(item + G);
        bf16x8 qf[4];
#pragma unroll
        for (int ks = 0; ks < 4; ++ks) qf[ks] = *(const LAS bf16x8*)(Qs + n * TP + ks * 32 + fq * 8);
        asm volatile("s_waitcnt lgkmcnt(0)" ::: "memory");
#pragma unroll
        for (int mb = 0; mb < 8; ++mb) {
            f32x4 s = {0.f, 0.f, 0.f, 0.f};
#pragma unroll
            for (int ks = 0; ks < 4; ++ks) { const bf16x8 kf = *(const LAS bf16x8*)(Ks + (16 * mb + fr) * TP + ks * 32 + fq * 8); s = MFMA16(kf, qf[ks], s); }
#pragma unroll
            for (int r = 0; r < 4; ++r) { const int d = n - (16 * mb + 4 * fq + r); s[r] *= d >= 0 ? exp2f(l2f * (float)d) : exp2f(l2b * (float)(-d)); }
            *(LAS u32x2*)(Qs + n * TP + 16 * mb + 4 * fq) = pack4(s);
        }
        asm volatile("s_waitcnt lgkmcnt(0)" ::: "memory");
        bf16x8 wf[4];
#pragma unroll
        for (int ks = 0; ks < 4; ++ks) wf[ks] = *(const LAS bf16x8*)(Qs + n * TP + ks * 32 + fq * 8);
        f32x4 o[8]; float sm = 0.f;
#pragma unroll
        for (int eb = 0; eb < 8; ++eb) {
            f32x4 a = {0.f, 0.f, 0.f, 0.f};
#pragma unroll
            for (int ks = 0; ks < 4; ++ks) { const bf16x8 vf = *(const LAS bf16x8*)(Vt + (16 * eb + fr) * TP + ks * 32 + fq * 8); a = MFMA16(vf, wf[ks], a); }
            { const unsigned f0 = cf[eb >> 1][2 * (eb & 1)], f1 = cf[eb >> 1][2 * (eb & 1) + 1], b0 = cb[eb >> 1][2 * (eb & 1)], b1 = cb[eb >> 1][2 * (eb & 1) + 1];
              a[0] += bf_lo(f0) + bf_lo(b0); a[1] += bf_hi(f0) + bf_hi(b0); a[2] += bf_lo(f1) + bf_lo(b1); a[3] += bf_hi(f1) + bf_hi(b1); }
            o[eb] = a; sm += sum4(a);
        }
        sm += __shfl_xor(sm, 16); sm += __shfl_xor(sm, 32);
        const float mean = sm * (1.0f / 128.f); float vs = 0.f;
#pragma unroll
        for (int eb = 0; eb < 8; ++eb) { o[eb] = o[eb] - mean; vs += sq4(o[eb]); }
        vs += __shfl_xor(vs, 16); vs += __shfl_xor(vs, 32);
        const float rstd = rsqrtf(vs * (1.0f / 128.f) + EPS);
#pragma unroll
        for (int a4 = 0; a4 < 4; ++a4) {
            const int col = h * 128 + 32 * a4 + 8 * fq;
            const f32x4 gw0 = *(const f32x4*)(gnw + col), gw1 = *(const f32x4*)(gnw + col + 4);
            const u32x4 g4 = gg[a4]; const f32x4 o0 = o[2 * a4], o1 = o[2 * a4 + 1];
            f32x4 r0, r1;
            r0[0] = bf_lo(g4.x) * (o0[0] * rstd * gw0[0]); r0[1] = bf_hi(g4.x) * (o0[1] * rstd * gw0[1]); r0[2] = bf_lo(g4.y) * (o0[2] * rstd * gw0[2]); r0[3] = bf_hi(g4.y) * (o0[3] * rstd * gw0[3]);
            r1[0] = bf_lo(g4.z) * (o1[0] * rstd * gw1[0]); r1[1] = bf_hi(g4.z) * (o1[1] * rstd * gw1[1]); r1[2] = bf_lo(g4.w) * (o1[2] * rstd * gw1[2]); r1[3] = bf_hi(g4.w) * (o1[3] * rstd * gw1[3]);
            u32x4 w4; w4.x = cvt_pk_bf16(r0[0], r0[1]); w4.y = cvt_pk_bf16(r0[2], r0[3]); w4.z = cvt_pk_bf16(r1[0], r1[1]); w4.w = cvt_pk_bf16(r1[2], r1[3]);
            *(u32x4*)(MIX + (size_t)row * DM + col) = w4;
        }
        LBAR();
    }
#undef IN_LOAD
}

struct Args { const float* in[17]; float* out; unsigned char* ws; };

#define XB_TMO      128
#define XB_XCNT(j)  (256  + 64 * (j))
#define XB_XSUB(j)  (1280 + 64 * (j))
#define XB_XGEN(j)  (2304 + 64 * (j))
#define XB_TOP      3328
#define XB_TOPGEN   3392
#define XCD_BAR_WORDS 3456
#define XB_SPIN_CAP (1u << 18)

__device__ __forceinline__ unsigned xb_ld(unsigned* p)              { return __hip_atomic_load(p, __ATOMIC_RELAXED, __HIP_MEMORY_SCOPE_AGENT); }
__device__ __forceinline__ unsigned xb_add(unsigned* p, unsigned v) { return __hip_atomic_fetch_add(p, v, __ATOMIC_RELAXED, __HIP_MEMORY_SCOPE_AGENT); }
__device__ __forceinline__ unsigned xb_xcc_id() { return (unsigned)__builtin_amdgcn_s_getreg((3 << 11) | 20) & 0xFu; }
#define XB_SPIN(cond, bar) do { unsigned _sp = 0; while (cond) { __builtin_amdgcn_s_sleep(1); \
    if ((++_sp & 255u) == 0u) { if (xb_ld(&(bar)[XB_TMO])) break; if (_sp > XB_SPIN_CAP) { atomicAdd(&(bar)[XB_TMO], 1u); break; } } } } while (0)

struct XcdBarrier {
    unsigned* bar; unsigned x;
    volatile LAS unsigned* st;
};

__device__ __forceinline__ XcdBarrier xcd_barrier_post(unsigned* bar, volatile LAS unsigned* st) {
    XcdBarrier b; b.bar = bar; b.x = xb_xcc_id(); b.st = st;
    if (threadIdx.x == 0) (void)xb_add(&bar[XB_XCNT(b.x)], 1u);
    return b;
}
__device__ __forceinline__ void xcd_barrier_complete(unsigned* bar, unsigned x, unsigned& nloc, unsigned& nx) {
    const unsigned G = gridDim.x * gridDim.y * gridDim.z;
    unsigned sum, cnt, mine, sp = 0u;
    for (;;) {
        sum = 0u; cnt = 0u; mine = 0u;
#pragma unroll
        for (unsigned j = 0; j < 16; ++j) { const unsigned c = xb_ld(&bar[XB_XCNT(j)]); sum += c; cnt += (c > 0u) ? 1u : 0u; mine = (j == x) ? c : mine; }
        if (sum == G) break;
        __builtin_amdgcn_s_sleep(1);
        if ((++sp & 255u) == 0u) { if (xb_ld(&bar[XB_TMO])) break; if (sp > XB_SPIN_CAP) { atomicAdd(&bar[XB_TMO], 1u); break; } }
    }
    nloc = mine > 0u ? mine : 1u; nx = cnt > 0u ? cnt : 1u;
}

__device__ __forceinline__ void xcd_barrier(const XcdBarrier& b) {
    asm volatile("s_waitcnt vmcnt(0)" ::: "memory");
    __syncthreads();
    if (threadIdx.x == 0) {
        unsigned* bar = b.bar;
        __builtin_amdgcn_s_waitcnt(0);
        unsigned nloc = b.st[0], nx = b.st[1];
        if (nloc == 0u) { xcd_barrier_complete(bar, b.x, nloc, nx); b.st[0] = nloc; b.st[1] = nx; }
        const unsigned old = xb_add(&bar[XB_XSUB(b.x)], 1u);
        const unsigned gen = old / nloc;
        if (old + 1u == (gen + 1u) * nloc) {
            __builtin_amdgcn_fence(__ATOMIC_RELEASE, "agent");
            asm volatile("s_waitcnt vmcnt(0)" ::: "memory");
            const unsigned og = xb_add(&bar[XB_TOP], 1u);
            const unsigned tg = og / nx;
            if (og + 1u == (tg + 1u) * nx) xb_add(&bar[XB_TOPGEN], 1u);
            else XB_SPIN(xb_ld(&bar[XB_TOPGEN]) == tg, bar);
            __builtin_amdgcn_fence(__ATOMIC_ACQUIRE, "agent");
            xb_add(&bar[XB_XGEN(b.x)], 1u);
            asm volatile("s_waitcnt vmcnt(0)" ::: "memory");
        } else {
            XB_SPIN(xb_ld(&bar[XB_XGEN(b.x)]) == gen, bar);
            __builtin_amdgcn_fence(__ATOMIC_ACQUIRE, "agent");
            asm volatile("s_waitcnt vmcnt(0)" ::: "memory");
        }
    }
    __syncthreads();
}

#if REP_MASK
#define STAMP(k) do { if (blockIdx.x == 0 && threadIdx.x == 0) ((volatile LAS unsigned*)(lds + MISC_OFF + 64))[k] = (unsigned)__builtin_amdgcn_s_memrealtime(); } while (0)
#else
#define STAMP(k) do { } while (0)
#endif
__global__ void __launch_bounds__(512, 2) fwd_kernel(Args a) {
    extern __shared__ __attribute__((aligned(16))) unsigned char lds_raw[];
    LAS unsigned char* lds = (LAS unsigned char*)lds_raw;
    const int tid = threadIdx.x, lane = tid & 63, wave = __builtin_amdgcn_readfirstlane(tid >> 6);
    const int G = gridDim.x, bid = blockIdx.x;
    unsigned char* ws = a.ws;
    const float* xp = a.in[0]; const float* xs = a.in[1];
    bf16_t* Win_t = (bf16_t*)(ws + WS_WIN); bf16_t* Wout_t = (bf16_t*)(ws + WS_WOUT); bf16_t* Wup_t = (bf16_t*)(ws + WS_WUP); bf16_t* Wdown_t = (bf16_t*)(ws + WS_WDOWN);
    bf16_t* Zb = (bf16_t*)(ws + WS_Z); bf16_t* X1B = (bf16_t*)(ws + WS_X1B); bf16_t* ACT = (bf16_t*)(ws + WS_ACT); bf16_t* MIX = (bf16_t*)(ws + WS_MIX);
    float* HALO = (float*)(ws + WS_HALO); float* ROPE = (float*)(ws + WS_ROPE); float* RS1 = (float*)(ws + WS_RS1);
    float* SSQV = (float*)(ws + WS_SSQV); float* SSQ2 = (float*)(ws + WS_SSQ2); float* SSQ3 = (float*)(ws + WS_SSQ3);
    unsigned* CTL = (unsigned*)(ws + WS_CTL);
    bf16_t* X2B = (bf16_t*)(ws + WS_X1B);
    bf16_t* WSB = (bf16_t*)(ws + 335 * MiB);
    { volatile LAS unsigned* st_ = (volatile LAS unsigned*)(lds + MISC_OFF + 128); if (tid == 0) { st_[0] = 0u; st_[1] = 0u; } }
    __syncthreads();
    const XcdBarrier xbar = xcd_barrier_post(CTL + 1024, (volatile LAS unsigned*)(lds + MISC_OFF + 128));
    bf16_t* XB = (bf16_t*)a.out; bf16_t* crossF = (bf16_t*)a.out + (size_t)T * DM; bf16_t* crossB = crossF + (size_t)T * RW; float* X1 = a.out;

    STAMP(0);
    if (PH_MASK & 1) {
        LAS float* scr = (LAS float*)(lds + wave * 17408);
        const int gw = bid * 8 + wave, NGW = G * 8;
        for (int it = gw; it < (DM / 128) * (INC / 64); it += NGW) tr_pair<true>(a.in[3], DM, INC, Win_t, a.in[2], 1, scr, 2 * (it / (INC / 64)), it % (INC / 64), lane);
        for (int row = gw; row < T; row += 2 * NGW) {
            const int row2 = row + NGW;
            const float* xr = row < 8192 ? xp + (size_t)row * DM : xs + (size_t)(row - 8192) * DM;
            const float* xr2 = row2 < 8192 ? xp + (size_t)row2 * DM : xs + (size_t)(row2 - 8192) * DM;
            f32x4 v[8], u[8]; float s = 0.f, s2 = 0.f;
#pragma unroll
            for (int j = 0; j < 8; ++j) v[j] = *(const f32x4*)(xr + 256 * j + 4 * lane);
#pragma unroll
            for (int j = 0; j < 8; ++j) u[j] = *(const f32x4*)(xr2 + 256 * j + 4 * lane);
#pragma unroll
            for (int j = 0; j < 8; ++j) { s += sq4(v[j]); s2 += sq4(u[j]); }
            s = wave_sum(s); s2 = wave_sum(s2);
            if (lane == 0) { RS1[row] = rsqrtf(s * (1.0f / DM) + EPS); RS1[row2] = rsqrtf(s2 * (1.0f / DM) + EPS); }
#pragma unroll
            for (int j = 0; j < 8; ++j) { *(u32x2*)(XB + (size_t)row * DM + 256 * j + 4 * lane) = pack4(v[j]); *(u32x2*)(XB + (size_t)row2 * DM + 256 * j + 4 * lane) = pack4(u[j]); }
        }
        for (int e = bid * 512 + tid; e < 8 * 128 * 128 / 4; e += G * 512) *(u32x2*)(WSB + 4 * (size_t)e) = pack4(*(const f32x4*)(a.in[8] + 4 * (size_t)e));
        const float inv = (float)exp2(-(double)(tid & 63) * (13.287712379549449 / 64.0));
        for (int e = bid * 512 + tid; e < 8192 * 64; e += G * 512) {
            const int pos = e >> 6;
            const float ang = (float)pos * inv;
            double rev = (double)ang * 0.15915494309189535; rev -= floor(rev);
            const float fr_ = (float)rev;
            ROPE[2 * e] = __builtin_amdgcn_cosf(fr_); ROPE[2 * e + 1] = __builtin_amdgcn_sinf(fr_);
        }
    }
    xcd_barrier(xbar); STAMP(1);

    if (PH_MASK & 2) {
        pg8::Gemm g{XB, Win_t, T, INC, DM}; pg8::StaticOrder S; S.init(T, INC, G, bid);
        EpiIn E{Zb, RS1, ROPE, SSQV};
        pg8::gemm_phase<EpiIn, pg8::StaticOrder, true, true>(lds, g, S, E);
    }
    xcd_barrier(xbar); STAMP(2);

    if (PH_MASK & 4) {
        volatile LAS int* sh = (volatile LAS int*)(lds + MISC_OFF);
        int pending = -1;
        if (bid < 192) { const int x_ = bid & 7, j_ = bid >> 3, grp_ = j_ >> 2; pending = (grp_ >> 1) * 64 + x_ * 8 + (grp_ & 1) * 4 + (j_ & 3); }
        for (;;) {
            if (pending < 0) {
                if (tid == 0) sh[0] = 192 + (int)atomicAdd(CTL, 1u);
                __syncthreads();
                pending = sh[0];
                __syncthreads();
            }
            const int item = pending; pending = -1;
            if (item >= 192 + 1024 + TR_ITEMS) break;
            if (item < 192) scan_item(lds, item, Zb, crossF, crossB, a.in[4], a.in[5]);
            else if (item >= 192 + TR_ITEMS) sgu_item(lds, item - (192 + TR_ITEMS), Zb, SSQV, a.in[7], WSB, a.in[9], MIX);
            else {
                int r = item - 192; LAS float* scr = (LAS float*)(lds + wave * 17408);
                int lane_ = lane; asm volatile("" : "+v"(lane_));
                if (r < TR_OUT) tr_pair<false>(a.in[10], DM, DM, Wout_t, nullptr, 0, scr, 2 * (r >> 2), (r & 3) * 8 + wave, lane_);
                else if ((r -= TR_OUT) < TR_UP) tr_pair<true>(a.in[12], DM, FF2, Wup_t, a.in[11], 2, scr, 2 * (r / 22), (r % 22) * 8 + wave, lane_);
                else { r -= TR_UP; tr_pair<false>(a.in[15], FF, DM, Wdown_t, nullptr, 0, scr, 2 * (r >> 2), (r & 3) * 8 + wave, lane_); }
            }
        }
    }
    xcd_barrier(xbar); STAMP(3);

    if (PH_MASK & 8) inner_phase(lds, bid, G, Zb, crossF, crossB, a.in[6], a.in[4], a.in[5], MIX);
    xcd_barrier(xbar); STAMP(4);

    if (PH_MASK & 16) {
        pg8::Gemm g{MIX, Wout_t, T, DM, DM}; pg8::StaticOrder S; S.init(T, DM, G, bid);
        EpiRes<false> E{(const float*)XB, nullptr, X1, X1B, SSQ2};
        pg8::gemm_phase<EpiRes<false>, pg8::StaticOrder, true, true>(lds, g, S, E);
    }
    xcd_barrier(xbar); STAMP(5);

    if (PH_MASK & 32) {
        pg8::Gemm g{X1B, Wup_t, T, FF2, DM}; pg8::StaticOrder S; S.init(T, FF2, G, bid);
        EpiUp E{ACT, HALO, SSQ2, a.in[13], a.in[14], (LAS float*)(lds + EX_OFF)};
        pg8::gemm_phase<EpiUp, pg8::StaticOrder, true, true>(lds, g, S, E);
    }
    xcd_barrier(xbar); STAMP(6);

    if (PH_MASK & 64) {
        const float* cw = a.in[13]; const float* cb = a.in[14];
        for (int e = bid * 512 + tid; e < 128 * FF; e += G * 512) {
            const int idx = e / FF, c = e - idx * FF, p = idx >> 1, which = idx & 1;
            const int row = p * 256 + (which ? 255 : 0);
            const bool first = (row == 0) || (row == 4096) || (row == 8192), last = (row == 4095) || (row == 8191) || (row == 16383);
            const int pa = 256 * (c >> 7) + (c & 127), pb = pa + 128;
            const float* hp = HALO + (size_t)(p * 4) * FF2;
            float pra, prb, cua, cub, nxa, nxb;
            if (which == 0) {
                pra = first ? 0.f : hp[-(ptrdiff_t)FF2 + pa]; prb = first ? 0.f : hp[-(ptrdiff_t)FF2 + pb];
                cua = hp[pa]; cub = hp[pb]; nxa = hp[FF2 + pa]; nxb = hp[FF2 + pb];
            } else {
                pra = hp[2 * FF2 + pa]; prb = hp[2 * FF2 + pb]; cua = hp[3 * FF2 + pa]; cub = hp[3 * FF2 + pb];
                nxa = last ? 0.f : hp[4 * (size_t)FF2 + pa]; nxb = last ? 0.f : hp[4 * (size_t)FF2 + pb];
            }
            const float va = cw[c] * pra + cw[FF2 + c] * cua + cw[2 * FF2 + c] * nxa + cb[c];
            const float vb = cw[FF + c] * prb + cw[FF2 + FF + c] * cub + cw[2 * FF2 + FF + c] * nxb + cb[FF + c];
            ACT[(size_t)row * FF + c] = (bf16_t)(cvt_pk_bf16(silu_f(va) * vb, 0.f) & 0xffffu);
        }
    }
    xcd_barrier(xbar); STAMP(7);

    if (PH_MASK & 128) {
        pg8::Gemm g{ACT, Wdown_t, T, DM, FF}; pg8::StaticOrder S; S.init(T, DM, G, bid);
        EpiRes<true> E{nullptr, nullptr, (float*)X2B, X1B, SSQ3};
        pg8::gemm_phase<EpiRes<true>, pg8::StaticOrder, true, true>(lds, g, S, E);
    }
    xcd_barrier(xbar); STAMP(8);

    if (PH_MASK & 256) {
        const int gw = bid * 8 + wave, NGW = G * 8; const float* fw = a.in[16];
        for (int row = gw; row < T; row += NGW) {
            float s = lane < 32 ? SSQ3[(size_t)row * 32 + lane] : 0.f;
            s = wave_sum(s);
            const float rs = rsqrtf(s * (1.0f / DM) + EPS);
            float* orow = a.out + (size_t)row * DM; const bf16_t* xrow = X2B + (size_t)row * DM;
#pragma unroll
            for (int j = 0; j < 4; ++j) { const u32x4 xb = *(const u32x4*)(xrow + 512 * j + 8 * lane); const f32x4 w0 = *(const f32x4*)(fw + 512 * j + 8 * lane), w1 = *(const f32x4*)(fw + 512 * j + 8 * lane + 4);
                f32x4 o0, o1; o0[0] = bf_lo(xb.x) * rs * w0[0]; o0[1] = bf_hi(xb.x) * rs * w0[1]; o0[2] = bf_lo(xb.y) * rs * w0[2]; o0[3] = bf_hi(xb.y) * rs * w0[3];
                o1[0] = bf_lo(xb.z) * rs * w1[0]; o1[1] = bf_hi(xb.z) * rs * w1[1]; o1[2] = bf_lo(xb.w) * rs * w1[2]; o1[3] = bf_hi(xb.w) * rs * w1[3];
                *(f32x4*)(orow + 512 * j + 8 * lane) = o0; *(f32x4*)(orow + 512 * j + 8 * lane + 4) = o1; }
        }
    }
#if REP_MASK
    STAMP(9);
    if (blockIdx.x == 0 && threadIdx.x == 0) {
        volatile LAS unsigned* tsv = (volatile LAS unsigned*)(lds + MISC_OFF + 64);
        unsigned dt = 0;
#pragma unroll
        for (int k = 0; k < 9; ++k) if ((REP_MASK >> k) & 1) dt += tsv[k + 1] - tsv[k];
        const unsigned t0 = (unsigned)__builtin_amdgcn_s_memrealtime();
        while ((unsigned)__builtin_amdgcn_s_memrealtime() - t0 < dt) __builtin_amdgcn_s_sleep(8);
    }
#endif
}

extern "C" void kernel_launch(void* const* d_in, const int* in_sizes, int n_in, void* d_out, int out_size, void* d_ws, size_t ws_size, hipStream_t stream) {
    static int grid = 0;
    if (grid == 0) {
        if (n_in != 17 || out_size != 2 * T / 2 * DM || ws_size < WS_END) { fprintf(stderr, "kernel_launch: unexpected sizes n_in %d out %d ws %zu (need %zu)\n", n_in, out_size, ws_size, (size_t)WS_END); grid = -1; }
        else {
            int dev = 0, cus = 0, per_cu = 0;
            (void)hipGetDevice(&dev); (void)hipDeviceGetAttribute(&cus, hipDeviceAttributeMultiprocessorCount, dev);
            (void)hipFuncSetAttribute((const void*)fwd_kernel, hipFuncAttributeMaxDynamicSharedMemorySize, LDS_BYTES);
            (void)hipOccupancyMaxActiveBlocksPerMultiprocessor(&per_cu, (const void*)fwd_kernel, 512, LDS_BYTES);
            if (per_cu < 1 || cus < 1) { fprintf(stderr, "kernel_launch: occupancy query says %d blocks/CU on %d CUs\n", per_cu, cus); grid = -1; }
            else grid = cus;
        }
    }
    if (grid < 0) { (void)hipMemsetAsync(d_out, 0, (size_t)out_size * 4, stream); return; }
    (void)hipMemsetAsync((char*)d_ws + WS_CTL, 0, 65536, stream);
    Args a{};
    for (int i = 0; i < 17; ++i) a.in[i] = (const float*)d_in[i];
    a.out = (float*)d_out; a.ws = (unsigned char*)d_ws;
    void* kargs[] = {&a};
    const hipError_t e = hipLaunchCooperativeKernel((const void*)fwd_kernel, dim3(grid), dim3(512), kargs, LDS_BYTES, stream);
    if (e != hipSuccess) fprintf(stderr, "kernel_launch: cooperative launch failed: %s (grid %d)\n", hipGetErrorString(e), grid);
}
```

```cpp
#include <hip/hip_runtime.h>
#include <hip/hip_cooperative_groups.h>
#include <cstdio>
#include <cstdint>
namespace cg = cooperative_groups;
namespace pg8 {
#define PG8_LAS __attribute__((address_space(3)))
typedef unsigned short bf16_t;
typedef short bf16x8 __attribute__((ext_vector_type(8)));
typedef float f32x4 __attribute__((ext_vector_type(4)));
typedef unsigned u32x4 __attribute__((ext_vector_type(4)));
constexpr int BM = 256, BK = 64, HALF = 128, HTB = HALF * BK * 2  , STAGE_BYTES = 8 * HTB, NXCD = 8, WGM = 8;

__host__ __device__ __forceinline__ int lds_byte(int r, int c) { const int st = (r >> 4) * 2 + (c >> 5), rr = r & 15, cc = c & 31, ob = rr * 64 + cc * 2; return st * 1024 + (ob ^ (((ob >> 9) & 1) << 5)); }
__host__ __device__ __forceinline__ void stage_rc(int b, int& R, int& C) { const int st = b / 1024, sb = b % 1024, swz = sb ^ (((sb >> 9) & 1) << 5); R = (st >> 1) * 16 + swz / 64; C = (st & 1) * 32 + (swz % 64) / 2; }
__host__ __device__ __forceinline__ int perm32(int rho) { const int n = rho >> 4, i = rho & 15; return 8 * (i >> 2) + 4 * n + (i & 3); }

struct Unit { int pm, pn; };
struct Gemm { const bf16_t* A; const bf16_t* Bt; int M, N, K; };

struct StaticOrder {
    int nM, nN, nwg, G, c;
    __host__ __device__ void init(int M, int N, int G_, int c_) { nM = M / BM; nN = N / BM; nwg = nM * nN; G = G_; c = c_; }
    __host__ __device__ bool next(int i, Unit& u) const {
        const long L = (long)i * G + c; if (L >= nwg) return false;
        int wgid = (int)L; { const int q = nwg / NXCD, r = nwg % NXCD, xcd = wgid % NXCD, off = wgid / NXCD; wgid = (xcd < r ? xcd * (q + 1) : r * (q + 1) + (xcd - r) * q) + off; }
        const int nig = WGM * nN, gid = wgid / nig, fm = gid * WGM, gsz = (nM - fm) < WGM ? (nM - fm) : WGM;
        u.pm = fm + ((wgid % nig) % gsz); u.pn = (wgid % nig) / gsz; return true;
    }
    __device__ __forceinline__ void a_ready(const Unit&) const {}
    __device__ __forceinline__ void done(const Unit&) const {}
};

__device__ __forceinline__ unsigned cvt_pk_bf16(float lo, float hi) { unsigned r; asm volatile("v_cvt_pk_bf16_f32 %0, %1, %2" : "=v"(r) : "v"(lo), "v"(hi)); return r; }
template <class Epi, class Sched, bool ALIGN_EPI = false, bool SP2 = false>
__device__ __forceinline__ void gemm_phase(PG8_LAS unsigned char* lds, const Gemm g, const Sched& S, const Epi& E) {
    int tid_ = threadIdx.x; asm volatile("" : "+v"(tid_));
    const int tid = tid_, wid = __builtin_amdgcn_readfirstlane(tid >> 6), lane = tid & 63, wr = wid >> 2, wc = wid & 3, fr = lane & 15, fq = lane >> 4;
    const int K = g.K, nt = K / BK;
    unsigned voffA[2], voffB[2];
#pragma unroll
    for (int i = 0; i < 2; ++i) { int R, C; stage_rc(tid * 16 + i * 8192, R, C); const int Rb = Epi::PERM ? ((R & ~31) + perm32(R & 31)) : R;
        const int Ra = Epi::PERMA ? ((R & 64) + 4 * (R & 15) + ((R >> 4) & 3)) : R; voffA[i] = (unsigned)(Ra * K + C) * 2u; voffB[i] = (unsigned)(Rb * K + C) * 2u; }
    const size_t kstep = (size_t)(BK * 2);
    const size_t hstep = (size_t)HALF * K * 2;
    const size_t tstep = 2 * hstep;
    const unsigned ldsw = (unsigned)wid * 1024u;
    const int aoff = lds_byte(wr * 64 + fr, fq * 8), boff = lds_byte(wc * 32 + fr, fq * 8);
#define PG8_SA(b, h) (((b) * 2 + (h)) * HTB)
#define PG8_SB(b, h) ((4 + (b) * 2 + (h)) * HTB)
#define PG8_STAGE(bufoff, gbase, voff) do { _Pragma("unroll") for (int _i = 0; _i < 2; ++_i) \
        __builtin_amdgcn_global_load_lds((const unsigned*)((const char*)(gbase) + (voff)[_i]), (PG8_LAS unsigned*)(lds + (bufoff) + ldsw + _i * 8192), 16, 0, 0); } while (0)
#define PG8_LDA(dst, b, h) do { _Pragma("unroll") for (int m = 0; m < 4; ++m) _Pragma("unroll") for (int k = 0; k < 2; ++k) dst[m][k] = *(const PG8_LAS bf16x8*)(lds + PG8_SA(b, h) + aoff + m * 2048 + k * 1024); } while (0)
#define PG8_LDB(dst, b, h) do { _Pragma("unroll") for (int n = 0; n < 2; ++n) _Pragma("unroll") for (int k = 0; k < 2; ++k) dst[n][k] = *(const PG8_LAS bf16x8*)(lds + PG8_SB(b, h) + boff + n * 2048 + k * 1024); } while (0)
#define PG8_MMA(ai, bj, At, Bt) do { __builtin_amdgcn_s_setprio(1); _Pragma("unroll") for (int m = 0; m < 4; ++m) _Pragma("unroll") for (int n = 0; n < 2; ++n) _Pragma("unroll") for (int k = 0; k < 2; ++k) \
        acc[ai][bj][m][n] = __builtin_amdgcn_mfma_f32_16x16x32_bf16(Bt[n][k], At[m][k], acc[ai][bj][m][n], 0, 0, 0); __builtin_amdgcn_s_setprio(0); } while (0)
#define PG8_WAIT_V(n) asm volatile("s_waitcnt vmcnt(" #n ")" ::: "memory")
#define PG8_WAIT_L(n) asm volatile("s_waitcnt lgkmcnt(" #n ")" ::: "memory")
#define PG8_BAR __builtin_amdgcn_s_barrier()
#define PG8_SCHED __builtin_amdgcn_sched_barrier(0)
    Unit cur, nxt; int ui = 0;
    if (!S.next(0, cur)) return;
    f32x4 acc[2][2][4][2];
#pragma unroll
    for (int a = 0; a < 2; ++a)
#pragma unroll
        for (int b = 0; b < 2; ++b)
#pragma unroll
            for (int m = 0; m < 4; ++m)
#pragma unroll
                for (int n = 0; n < 2; ++n) acc[a][b][m][n] = (f32x4){0.f, 0.f, 0.f, 0.f};
    bf16x8 At[4][2], B0[2][2], B1[2][2];
    const char* cA = (const char*)g.A + (size_t)cur.pm * tstep; const char* cB = (const char*)g.Bt + (size_t)cur.pn * tstep;
    S.a_ready(cur);
    if constexpr (SP2) {
        PG8_STAGE(PG8_SB(0, 0), cB, voffB); PG8_STAGE(PG8_SB(0, 1), cB + hstep, voffB); PG8_STAGE(PG8_SA(0, 0), cA, voffA); PG8_STAGE(PG8_SA(0, 1), cA + hstep, voffA);
        if (wr == 1) PG8_BAR;
        PG8_WAIT_V(2); PG8_BAR;
        PG8_STAGE(PG8_SB(1, 0), cB + kstep, voffB); PG8_STAGE(PG8_SA(1, 0), cA + kstep, voffA); PG8_STAGE(PG8_SB(1, 1), cB + hstep + kstep, voffB);
        PG8_WAIT_V(6); PG8_BAR;
    } else {
        PG8_STAGE(PG8_SB(0, 0), cB, voffB); PG8_STAGE(PG8_SA(0, 0), cA, voffA); PG8_STAGE(PG8_SB(0, 1), cB + hstep, voffB); PG8_STAGE(PG8_SA(0, 1), cA + hstep, voffA);
        if (wr == 1) PG8_BAR;
        PG8_WAIT_V(4); PG8_BAR;
        PG8_STAGE(PG8_SB(1, 0), cB + kstep, voffB); PG8_STAGE(PG8_SA(1, 0), cA + kstep, voffA); PG8_STAGE(PG8_SB(1, 1), cB + hstep + kstep, voffB);
        PG8_WAIT_V(6); PG8_BAR;
    }
    for (;;) {
        const bool has_next = S.next(ui + 1, nxt);
        const char* nA = has_next ? (const char*)g.A + (size_t)nxt.pm * tstep : cA; const char* nB = has_next ? (const char*)g.Bt + (size_t)nxt.pn * tstep : cB;
        for (int t = 0; t < nt; t += 2) {
            const bool last = (t == nt - 2);
            const char* a1 = cA + (size_t)(t + 1) * kstep;
            const char* a2 = last ? nA : cA + (size_t)(t + 2) * kstep; const char* b2 = last ? nB : cB + (size_t)(t + 2) * kstep;
            const char* a3 = a2 + kstep; const char* b3 = b2 + kstep;
            if (last && has_next) S.a_ready(nxt);
            if constexpr (SP2) {
            PG8_LDB(B0, 0, 0); PG8_LDB(B1, 0, 1); PG8_SCHED; PG8_LDA(At, 0, 0); PG8_STAGE(PG8_SA(1, 1), a1 + hstep, voffA);
            PG8_WAIT_V(8); PG8_WAIT_L(0); PG8_BAR; PG8_MMA(0, 0, At, B0); PG8_MMA(0, 1, At, B1); PG8_BAR; PG8_SCHED;
            PG8_LDA(At, 0, 1); PG8_STAGE(PG8_SB(0, 0), b2, voffB); PG8_STAGE(PG8_SB(0, 1), b2 + hstep, voffB); PG8_STAGE(PG8_SA(0, 0), a2, voffA);
            PG8_WAIT_V(8); PG8_WAIT_L(0); PG8_BAR; PG8_MMA(1, 0, At, B0); PG8_MMA(1, 1, At, B1); PG8_BAR; PG8_SCHED;
            PG8_LDB(B0, 1, 0); PG8_LDB(B1, 1, 1); PG8_SCHED; PG8_LDA(At, 1, 0); PG8_STAGE(PG8_SA(0, 1), a2 + hstep, voffA);
            PG8_WAIT_V(8); PG8_WAIT_L(0); PG8_BAR; PG8_MMA(0, 0, At, B0); PG8_MMA(0, 1, At, B1); PG8_BAR; PG8_SCHED;
            PG8_LDA(At, 1, 1); PG8_STAGE(PG8_SB(1, 0), b3, voffB); PG8_STAGE(PG8_SB(1, 1), b3 + hstep, voffB); PG8_STAGE(PG8_SA(1, 0), a3, voffA);
            PG8_WAIT_V(8); PG8_WAIT_L(0); PG8_BAR; PG8_MMA(1, 0, At, B0); PG8_MMA(1, 1, At, B1); PG8_BAR; PG8_SCHED;
            } else {
            PG8_LDB(B0, 0, 0); PG8_SCHED; PG8_LDA(At, 0, 0); PG8_STAGE(PG8_SA(1, 1), a1 + hstep, voffA);
            PG8_WAIT_L(8); PG8_BAR; PG8_WAIT_L(0); PG8_MMA(0, 0, At, B0); PG8_BAR; PG8_SCHED;
            PG8_LDB(B1, 0, 1); PG8_STAGE(PG8_SB(0, 0), b2, voffB);
            PG8_BAR; PG8_WAIT_L(0); PG8_MMA(0, 1, At, B1); PG8_BAR;
            PG8_LDA(At, 0, 1); PG8_STAGE(PG8_SA(0, 0), a2, voffA);
            PG8_BAR; PG8_WAIT_L(0); PG8_MMA(1, 0, At, B0); PG8_BAR; PG8_SCHED;
            PG8_STAGE(PG8_SB(0, 1), b2 + hstep, voffB);
            PG8_WAIT_V(6); PG8_BAR; PG8_MMA(1, 1, At, B1); PG8_BAR;
            PG8_LDB(B0, 1, 0); PG8_SCHED; PG8_LDA(At, 1, 0); PG8_STAGE(PG8_SA(0, 1), a2 + hstep, voffA);
            PG8_WAIT_L(8); PG8_BAR; PG8_WAIT_L(0); PG8_MMA(0, 0, At, B0); PG8_BAR; PG8_SCHED;
            PG8_LDB(B1, 1, 1); PG8_STAGE(PG8_SB(1, 0), b3, voffB);
            PG8_BAR; PG8_WAIT_L(0); PG8_MMA(0, 1, At, B1); PG8_BAR;
            PG8_LDA(At, 1, 1); PG8_STAGE(PG8_SA(1, 0), a3, voffA);
            PG8_BAR; PG8_WAIT_L(0); PG8_MMA(1, 0, At, B0); PG8_BAR; PG8_SCHED;
            PG8_STAGE(PG8_SB(1, 1), b3 + hstep, voffB);
            PG8_WAIT_V(6); PG8_BAR; PG8_MMA(1, 1, At, B1); PG8_BAR;
            }
        }
        if constexpr (ALIGN_EPI) { if (wr == 0) PG8_BAR; }
        if constexpr (!Epi::AFTER_DRAIN) { E(acc, cur, wr, wc, fr, fq); S.done(cur); }
        if (!has_next) break;
#pragma unroll
        for (int a = 0; a < 2; ++a)
#pragma unroll
            for (int b = 0; b < 2; ++b)
#pragma unroll
                for (int m = 0; m < 4; ++m)
#pragma unroll
                    for (int n = 0; n < 2; ++n) acc[a][b][m][n] = (f32x4){0.f, 0.f, 0.f, 0.f};
        cur = nxt; cA = nA; cB = nB; ++ui;
        if constexpr (ALIGN_EPI) { if (wr == 1) PG8_BAR; }
    }
    PG8_WAIT_V(0);
    if constexpr (!ALIGN_EPI) { if (wr == 0) PG8_BAR; }
    PG8_BAR;
    if constexpr (Epi::AFTER_DRAIN) { E.fused(acc, cur, wr, wc, fr, fq, lds, wid, lane); S.done(cur); }
#undef PG8_SA
#undef PG8_SB
#undef PG8_STAGE
#undef PG8_LDA
#undef PG8_LDB
#undef PG8_MMA
#undef PG8_WAIT_V
#undef PG8_WAIT_L
#undef PG8_BAR
#undef PG8_SCHED
}
}

#ifndef PH_MASK
#define PH_MASK 0x1ff
#endif
#ifndef REP_MASK
#define REP_MASK 0
#endif
#define DI __device__ __forceinline__
#define LAS __attribute__((address_space(3)))
using pg8::bf16_t; using pg8::bf16x8; using pg8::f32x4; using pg8::u32x4; using pg8::cvt_pk_bf16;
typedef unsigned u32x2 __attribute__((ext_vector_type(2)));

constexpr int T = 16384, DM = 2048, INC = 6144, FF = 5632, FF2 = 11264, RW = 1024;
constexpr float EPS = 1e-6f, LOG2E = 1.4426950408889634f;
constexpr size_t MiB = 1u << 20;
constexpr size_t WS_CTL = 0, WS_ROPE = 1 * MiB, WS_WOUT = 5 * MiB, WS_WUP = 13 * MiB, WS_WDOWN = 57 * MiB;
constexpr size_t WS_Z = 79 * MiB;
constexpr size_t WS_X1B = 79 * MiB;
constexpr size_t WS_ACT = 143 * MiB;
constexpr size_t WS_WIN = 271 * MiB;
constexpr size_t WS_MIX = 271 * MiB;
constexpr size_t WS_HALO = 319 * MiB;
constexpr size_t WS_RS1 = 336 * MiB, WS_SSQV = 337 * MiB, WS_SSQ2 = 338 * MiB, WS_SSQ3 = 340 * MiB, WS_END = 342 * MiB;
constexpr int RING_BYTES = 131072, EX_OFF = 131072, MISC_OFF = 139264, LDS_BYTES = 147456;
constexpr int TP = 136;
constexpr int TR_OUT = (DM / 128) * (DM / 512), TR_UP = (DM / 128) * (FF2 / 512), TR_DN = (FF / 128) * (DM / 512), TR_ITEMS = TR_OUT + TR_UP + TR_DN;

DI float silu_f(float x) { return x * __builtin_amdgcn_rcpf(1.f + __builtin_amdgcn_exp2f(-LOG2E * x)); }
DI float gelu_f(float x) { const float u = x + 0.044715f * x * x * x; return x * __builtin_amdgcn_rcpf(1.f + __builtin_amdgcn_exp2f(-2.f * 0.7978845608028654f * LOG2E * u)); }
DI f32x4 silu4(f32x4 x) { const f32x4 t = x * (-LOG2E); f32x4 e; e[0] = __builtin_amdgcn_exp2f(t[0]); e[1] = __builtin_amdgcn_exp2f(t[1]); e[2] = __builtin_amdgcn_exp2f(t[2]); e[3] = __builtin_amdgcn_exp2f(t[3]);
    const f32x4 d = e + 1.0f; f32x4 r; r[0] = __builtin_amdgcn_rcpf(d[0]); r[1] = __builtin_amdgcn_rcpf(d[1]); r[2] = __builtin_amdgcn_rcpf(d[2]); r[3] = __builtin_amdgcn_rcpf(d[3]); return x * r; }
DI f32x4 gelu4(f32x4 x) { const f32x4 u = x * (x * x * 0.044715f + 1.0f); const f32x4 t = u * (-2.f * 0.7978845608028654f * LOG2E);
    f32x4 e; e[0] = __builtin_amdgcn_exp2f(t[0]); e[1] = __builtin_amdgcn_exp2f(t[1]); e[2] = __builtin_amdgcn_exp2f(t[2]); e[3] = __builtin_amdgcn_exp2f(t[3]);
    const f32x4 d = e + 1.0f; f32x4 r; r[0] = __builtin_amdgcn_rcpf(d[0]); r[1] = __builtin_amdgcn_rcpf(d[1]); r[2] = __builtin_amdgcn_rcpf(d[2]); r[3] = __builtin_amdgcn_rcpf(d[3]); return x * r; }
DI float bf_lo(unsigned w) { return __uint_as_float(w << 16); }
DI float bf_hi(unsigned w) { return __uint_as_float(w & 0xffff0000u); }
DI unsigned short u16_of(const u32x4& v, int e) { const unsigned w = v[e >> 1]; return (unsigned short)((e & 1) ? (w >> 16) : (w & 0xffffu)); }
DI u32x2 pack4(const f32x4& v) { u32x2 r; r.x = cvt_pk_bf16(v[0], v[1]); r.y = cvt_pk_bf16(v[2], v[3]); return r; }
DI float sum4(const f32x4& v) { return (v[0] + v[1]) + (v[2] + v[3]); }
DI float sq4(const f32x4& v) { return (v[0] * v[0] + v[1] * v[1]) + (v[2] * v[2] + v[3] * v[3]); }
DI float wave_sum(float v) {
#pragma unroll
    for (int o = 1; o < 64; o <<= 1) v += __shfl_xor(v, o);
    return v;
}
#define LBAR() do { asm volatile("s_waitcnt lgkmcnt(0)" ::: "memory"); __builtin_amdgcn_s_barrier(); asm volatile("" ::: "memory"); } while (0)
#define MFMA16(a, b, c) __builtin_amdgcn_mfma_f32_16x16x32_bf16((a), (b), (c), 0, 0, 0)

struct EpiIn {
    static constexpr bool PERM = true, AFTER_DRAIN = false, PERMA = false;
    bf16_t* Z; const float* rs1; const float* rope; float* ssqv;
    DI void operator()(const f32x4 (&acc)[2][2][4][2], const pg8::Unit& u, int wr, int wc, int fr, int fq) const {
        const int region = u.pn >> 2;
#pragma unroll
        for (int ai = 0; ai < 2; ++ai)
#pragma unroll
            for (int m = 0; m < 4; ++m) {
                const int row = u.pm * 256 + ai * 128 + wr * 64 + m * 16 + fr;
                const float rs = rs1[row];
                bf16_t* zr = Z + (size_t)row * INC;
                if (region < 2) {
                    const int pos = row < 4096 ? row : (row < 8192 ? row - 4096 : row - 8192);
                    const f32x4* rp = (const f32x4*)(rope + ((size_t)pos * 64 + 16 * wc + 4 * fq) * 2);
                    const f32x4 cs0 = rp[0], cs1 = rp[1];
#pragma unroll
                    for (int bj = 0; bj < 2; ++bj) {
                        const f32x4 x1 = acc[ai][bj][m][0] * rs, x2 = acc[ai][bj][m][1] * rs;
                        f32x4 o1, o2;
                        o1[0] = x1[0] * cs0[0] - x2[0] * cs0[1]; o2[0] = x2[0] * cs0[0] + x1[0] * cs0[1];
                        o1[1] = x1[1] * cs0[2] - x2[1] * cs0[3]; o2[1] = x2[1] * cs0[2] + x1[1] * cs0[3];
                        o1[2] = x1[2] * cs1[0] - x2[2] * cs1[1]; o2[2] = x2[2] * cs1[0] + x1[2] * cs1[1];
                        o1[3] = x1[3] * cs1[2] - x2[3] * cs1[3]; o2[3] = x2[3] * cs1[2] + x1[3] * cs1[3];
                        const int col = region * 1024 + ((u.pn & 3) * 2 + bj) * 128 + 16 * wc + 4 * fq;
                        *(u32x2*)(zr + col) = pack4(o1); *(u32x2*)(zr + col + 64) = pack4(o2);
                    }
                } else {
                    float ss = 0.f;
#pragma unroll
                    for (int bj = 0; bj < 2; ++bj) {
                        f32x4 v0 = acc[ai][bj][m][0] * rs, v1 = acc[ai][bj][m][1] * rs;
                        if (region == 3) { v0 = silu4(v0); v1 = silu4(v1); }
                        else if (region >= 4) { v0 = gelu4(v0); v1 = gelu4(v1); }
                        ss += sq4(v0) + sq4(v1);
                        u32x4 w4; w4.x = cvt_pk_bf16(v0[0], v0[1]); w4.y = cvt_pk_bf16(v0[2], v0[3]); w4.z = cvt_pk_bf16(v1[0], v1[1]); w4.w = cvt_pk_bf16(v1[2], v1[3]);
                        *(u32x4*)(zr + u.pn * 256 + bj * 128 + 32 * wc + 8 * fq) = w4;
                    }
                    if (region == 5) { ss += __shfl_xor(ss, 16); ss += __shfl_xor(ss, 32); if (fq == 0) ssqv[(size_t)row * 16 + (u.pn - 20) * 4 + wc] = ss; }
                }
            }
    }
};

template <bool DOWN> struct EpiRes {
    static constexpr bool PERM = true, AFTER_DRAIN = false, PERMA = false;
    const float* xp; const float* xs; float* X1; bf16_t* X1B; float* ssq;
    DI void operator()(const f32x4 (&acc)[2][2][4][2], const pg8::Unit& u, int wr, int wc, int fr, int fq) const {
#pragma unroll
        for (int ai = 0; ai < 2; ++ai)
#pragma unroll
            for (int m = 0; m < 4; ++m) {
                const int row = u.pm * 256 + ai * 128 + wr * 64 + m * 16 + fr;
                float ss = 0.f;
#pragma unroll
                for (int bj = 0; bj < 2; ++bj) {
                    const int col = u.pn * 256 + bj * 128 + 32 * wc + 8 * fq;
                    f32x4 b0, b1;
                    if (DOWN) { const u32x4 xb = *(const u32x4*)(X1B + (size_t)row * DM + col); b0[0] = bf_lo(xb.x); b0[1] = bf_hi(xb.x); b0[2] = bf_lo(xb.y); b0[3] = bf_hi(xb.y); b1[0] = bf_lo(xb.z); b1[1] = bf_hi(xb.z); b1[2] = bf_lo(xb.w); b1[3] = bf_hi(xb.w); }
                    else { const u32x4 xb = *(const u32x4*)((const bf16_t*)xp + (size_t)row * DM + col); b0[0] = bf_lo(xb.x); b0[1] = bf_hi(xb.x); b0[2] = bf_lo(xb.y); b0[3] = bf_hi(xb.y); b1[0] = bf_lo(xb.z); b1[1] = bf_hi(xb.z); b1[2] = bf_lo(xb.w); b1[3] = bf_hi(xb.w); }
                    const f32x4 v0 = acc[ai][bj][m][0] + b0, v1 = acc[ai][bj][m][1] + b1;
                    ss += sq4(v0) + sq4(v1);
                    if (DOWN) { u32x4 w4; w4.x = cvt_pk_bf16(v0[0], v0[1]); w4.y = cvt_pk_bf16(v0[2], v0[3]); w4.z = cvt_pk_bf16(v1[0], v1[1]); w4.w = cvt_pk_bf16(v1[2], v1[3]);
                        *(u32x4*)((bf16_t*)X1 + (size_t)row * DM + col) = w4; }
                    if (!DOWN) { u32x4 w4; w4.x = cvt_pk_bf16(v0[0], v0[1]); w4.y = cvt_pk_bf16(v0[2], v0[3]); w4.z = cvt_pk_bf16(v1[0], v1[1]); w4.w = cvt_pk_bf16(v1[2], v1[3]);
                        *(u32x4*)(X1B + (size_t)row * DM + col) = w4; }
                }
                ss += __shfl_xor(ss, 16); ss += __shfl_xor(ss, 32);
                if (fq == 0) ssq[(size_t)row * 32 + u.pn * 4 + wc] = ss;
            }
    }
};

struct EpiUp {
    static constexpr bool PERM = true, AFTER_DRAIN = false, PERMA = true;
    bf16_t* ACT; float* HALO; const float* ssq2; const float* convw; const float* convb; LAS float* ex;
    DI void operator()(const f32x4 (&acc)[2][2][4][2], const pg8::Unit& u, int wr, int wc, int fr, int fq) const {
        asm volatile("" : "+v"(fr), "+v"(fq));
        asm volatile("" : "+s"(wr), "+s"(wc));
        const int lane = fq * 16 + fr;
        const int tcol = 32 * wc + 8 * fq;
        float rs[2][4];
#pragma unroll
        for (int ai = 0; ai < 2; ++ai) {
#pragma unroll
            for (int m = 0; m < 4; ++m) {
                const int row = u.pm * 256 + ai * 128 + wr * 64 + 4 * fr + m;
                const f32x4* p = (const f32x4*)(ssq2 + (size_t)row * 32 + fq * 8);
                float s = sum4(p[0]) + sum4(p[1]);
                s += __shfl_xor(s, 16); s += __shfl_xor(s, 32);
                rs[ai][m] = rsqrtf(s * (1.0f / DM) + EPS);
            }
            const int b = 2 * ai + wr;
            if (fr == 0 || fr == 15) {
                const bool lo = fr == 0;
#pragma unroll
                for (int bj = 0; bj < 2; ++bj)
#pragma unroll
                    for (int n = 0; n < 2; ++n) {
                        const f32x4 a0 = acc[ai][bj][0][n] * rs[ai][0], a3 = acc[ai][bj][3][n] * rs[ai][3];
                        f32x4 val; val[0] = lo ? a0[0] : a3[0]; val[1] = lo ? a0[1] : a3[1]; val[2] = lo ? a0[2] : a3[2]; val[3] = lo ? a0[3] : a3[3];
                        *(LAS f32x4*)(ex + (b * 2 + (lo ? 0 : 1)) * 256 + bj * 128 + tcol + 4 * n) = val;
                    }
            }
        }
        {
            const bool hfirst = (wr == 0 && fr == 0), hlast = (wr == 1 && fr == 15);
            if (hfirst || hlast) {
#pragma unroll
                for (int k = 0; k < 2; ++k)
#pragma unroll
                    for (int bj = 0; bj < 2; ++bj)
#pragma unroll
                        for (int n = 0; n < 2; ++n) {
                            const f32x4 a0 = acc[0][bj][k][n] * rs[0][k], a1 = acc[1][bj][2 + k][n] * rs[1][2 + k];
                            f32x4 val; val[0] = hfirst ? a0[0] : a1[0]; val[1] = hfirst ? a0[1] : a1[1]; val[2] = hfirst ? a0[2] : a1[2]; val[3] = hfirst ? a0[3] : a1[3];
                            *(f32x4*)(HALO + (size_t)(u.pm * 4 + (hfirst ? k : 2 + k)) * FF2 + u.pn * 256 + bj * 128 + tcol + 4 * n) = val;
                        }
            }
        }
        LBAR();
        const int src_dn = (lane & 48) | ((fr + 15) & 15), src_up = (lane & 48) | ((fr + 1) & 15);
#pragma unroll
        for (int n = 0; n < 2; ++n) {
            const int ca = u.pn * 128 + tcol + 4 * n;
            f32x4 cw[2][4];
#pragma unroll
            for (int bj = 0; bj < 2; ++bj) { cw[bj][0] = *(const f32x4*)(convw + ca + bj * FF); cw[bj][1] = *(const f32x4*)(convw + FF2 + ca + bj * FF); cw[bj][2] = *(const f32x4*)(convw + 2 * FF2 + ca + bj * FF); cw[bj][3] = *(const f32x4*)(convb + ca + bj * FF); }
#pragma unroll
            for (int ai = 0; ai < 2; ++ai) {
                const int b = 2 * ai + wr;
                f32x4 cva[4], outv[4];
#pragma unroll
                for (int bj = 0; bj < 2; ++bj) {
                    f32x4 v[4];
#pragma unroll
                    for (int m = 0; m < 4; ++m) v[m] = acc[ai][bj][m][n] * rs[ai][m];
                    f32x4 prevv, nextv;
#pragma unroll
                    for (int i = 0; i < 4; ++i) {
                        prevv[i] = __uint_as_float((unsigned)__builtin_amdgcn_update_dpp(0, (int)__float_as_uint(v[3][i]), 0x111, 0xf, 0xf, false));
                        nextv[i] = __uint_as_float((unsigned)__builtin_amdgcn_update_dpp(0, (int)__float_as_uint(v[0][i]), 0x101, 0xf, 0xf, false));
                    }
                    if (fr == 0) prevv = *(const LAS f32x4*)(ex + (((b > 0 ? b - 1 : 0)) * 2 + 1) * 256 + bj * 128 + tcol + 4 * n);
                    if (fr == 15) nextv = *(const LAS f32x4*)(ex + (((b < 3 ? b + 1 : 3)) * 2 + 0) * 256 + bj * 128 + tcol + 4 * n);
#pragma unroll
                    for (int m = 0; m < 4; ++m) {
                        const f32x4 pv = m == 0 ? prevv : v[m > 0 ? m - 1 : 0], nv = m == 3 ? nextv : v[m < 3 ? m + 1 : 3];
                        const f32x4 cv = cw[bj][0] * pv + cw[bj][1] * v[m] + cw[bj][2] * nv + cw[bj][3];
                        if (bj == 0) cva[m] = cv;
                        else {
                            outv[m] = silu4(cva[m]) * cv;
                        }
                    }
                }
#pragma unroll
                for (int m = 0; m < 4; ++m) {
                    const int tr = ai * 128 + wr * 64 + 4 * fr + m;
                    if (tr != 0 && tr != 255) *(u32x2*)(ACT + (size_t)(u.pm * 256 + tr) * FF + ca) = pack4(outv[m]);
                }
                __builtin_amdgcn_sched_barrier(0);
            }
        }
    }
};

DI void tr_load(f32x4 (&v)[16], const float* W, int N, int kb, int nb, int lane) {
    const int k0 = 64 * kb, n0 = 64 * nb;
#pragma unroll
    for (int i = 0; i < 16; ++i) v[i] = __builtin_nontemporal_load((const f32x4*)(W + (size_t)(k0 + 4 * i + (lane >> 4)) * N + n0 + 4 * (lane & 15)));
}
template <bool SCALE> DI void tr_finish(const f32x4 (&v)[16], const float (&ks)[16], int K, bf16_t* WT, int mode, LAS float* scr, int kb, int nb, int lane) {
    const int k0 = 64 * kb, n0 = 64 * nb;
#pragma unroll
    for (int i = 0; i < 16; ++i) { const int kk = 4 * i + (lane >> 4); *(LAS f32x4*)(scr + kk * 68 + 4 * (lane & 15)) = SCALE ? v[i] * ks[i] : v[i]; }
    asm volatile("s_waitcnt lgkmcnt(0)" ::: "memory");
    const int ncol = n0 + lane;
    int prow = ncol; float sc = 1.f;
    if (mode == 1) { const int region = ncol >> 10; if (region < 2) { const int cc = ncol & 127; prow = (ncol & ~127) + 32 * ((cc >> 4) & 3) + 8 * ((cc >> 2) & 3) + 4 * (cc >> 6) + (cc & 3); if (region == 0) sc = 0.08838834764831845f; } }
    else if (mode == 2) { if (ncol < FF) prow = 256 * (ncol >> 7) + (ncol & 127); else { const int nn = ncol - FF; prow = 256 * (nn >> 7) + 128 + (nn & 127); } }
    bf16_t* orow = WT + (size_t)prow * K + k0;
#pragma unroll
    for (int j = 0; j < 8; ++j) {
        const LAS float* sp = scr + (8 * j) * 68 + lane;
        u32x4 o; o.x = cvt_pk_bf16(sp[0 * 68] * sc, sp[1 * 68] * sc); o.y = cvt_pk_bf16(sp[2 * 68] * sc, sp[3 * 68] * sc); o.z = cvt_pk_bf16(sp[4 * 68] * sc, sp[5 * 68] * sc); o.w = cvt_pk_bf16(sp[6 * 68] * sc, sp[7 * 68] * sc);
        *(u32x4*)(orow + 8 * j) = o;
    }
    asm volatile("s_waitcnt lgkmcnt(0)" ::: "memory");
}
template <bool SCALE> DI void tr_pair(const float* W, int K, int N, bf16_t* WT, const float* kscale, int mode, LAS float* scr, int kb0, int nb, int lane) {
    float ksa[16], ksb[16];
#pragma unroll
    for (int i = 0; i < 16; ++i) { ksa[i] = SCALE ? kscale[64 * kb0 + 4 * i + (lane >> 4)] : 1.f; ksb[i] = SCALE ? kscale[64 * kb0 + 64 + 4 * i + (lane >> 4)] : 1.f; }
    f32x4 va[16], vb[16];
    tr_load(va, W, N, kb0, nb, lane); tr_load(vb, W, N, kb0 + 1, nb, lane);
    tr_finish<SCALE>(va, ksa, K, WT, mode, scr, kb0, nb, lane);
    tr_finish<SCALE>(vb, ksb, K, WT, mode, scr, kb0 + 1, nb, lane);
}

typedef short s16x4 __attribute__((ext_vector_type(4)));
DI bf16x8 tr_frag(const LAS bf16_t* tile, int pitch, int tok0, int f0, int lane) {
    const int i = lane & 15, q = i >> 2, p = i & 3, fq = lane >> 4;
    LAS bf16_t* a = (LAS bf16_t*)tile + (tok0 + 8 * fq + q) * pitch + f0 + 4 * p;
    const s16x4 lo = __builtin_amdgcn_ds_read_tr16_b64_v4i16((LAS s16x4*)a);
    const s16x4 hi = __builtin_amdgcn_ds_read_tr16_b64_v4i16((LAS s16x4*)(a + 4 * pitch));
    return __builtin_shufflevector(lo, hi, 0, 1, 2, 3, 4, 5, 6, 7);
}
constexpr int VP = 40;

DI void scan_item(LAS unsigned char* lds, int item, const bf16_t* Z, bf16_t* crossF, bf16_t* crossB, const float* lgf, const float* lgb) {
    const int tid = threadIdx.x, lane = tid & 63, w = tid >> 6, fr = lane & 15, fq = lane >> 4;
    const int sidx = item >> 6, rem = item & 63, h = rem >> 3, dir = (rem >> 2) & 1, sl = rem & 3;
    const int rowbase = sidx == 0 ? 8192 : (sidx == 1 ? 0 : 4096), nch = sidx == 0 ? 64 : 32;
    const float l2g = (dir ? lgb[h] : lgf[h]) * LOG2E;
    const float decay = exp2f(l2g * 128.f);
    bf16_t* cross = dir ? crossB : crossF;
    LAS bf16_t* Qn = (LAS bf16_t*)lds; LAS bf16_t* Kn = Qn + 128 * TP; LAS bf16_t* Vn = Kn + 128 * TP; LAS bf16_t* Rt = Vn + 128 * VP;
    f32x4 racc[2]; racc[0] = (f32x4){0.f, 0.f, 0.f, 0.f}; racc[1] = racc[0];
    const int vr = tid >> 2, vc = tid & 3;
    const float zeta = exp2f(l2g * (float)(dir ? vr : 127 - vr));
    const int n = 16 * w + fr;
    const float xi = exp2f(l2g * (float)(dir ? 128 - n : n + 1));
    const bf16_t* zbase = Z + (size_t)rowbase * INC + h * 128;
    u32x4 qA[4], kA[4], vA, qB[4], kB[4], vB, qC[4], kC[4], vC, qD[4], kD[4], vD;
#define SC_LOAD(Q_, K_, V_, s_) do { const int c_ = dir ? nch - 1 - (s_) : (s_); const bf16_t* zb = zbase + (size_t)c_ * 128 * INC; \
        _Pragma("unroll") for (int i = 0; i < 4; ++i) { const int v = tid + 512 * i; Q_[i] = *(const u32x4*)(zb + (size_t)(v >> 4) * INC + (v & 15) * 8); K_[i] = *(const u32x4*)(zb + (size_t)(v >> 4) * INC + 1024 + (v & 15) * 8); } \
        V_ = *(const u32x4*)(zb + (size_t)vr * INC + 2048 + sl * 32 + vc * 8); } while (0)
#define SC_STEP(Q_, K_, V_, s_) do { const int c_ = dir ? nch - 1 - (s_) : (s_); const int row0 = rowbase + c_ * 128; \
        _Pragma("unroll") for (int i = 0; i < 4; ++i) { const int v = tid + 512 * i; *(LAS u32x4*)(Qn + (v >> 4) * TP + (v & 15) * 8) = Q_[i]; *(LAS u32x4*)(Kn + (v >> 4) * TP + (v & 15) * 8) = K_[i]; } \
        { u32x4 o; _Pragma("unroll") for (int e = 0; e < 4; ++e) o[e] = cvt_pk_bf16(bf_lo(V_[e]) * zeta, bf_hi(V_[e]) * zeta); *(LAS u32x4*)(Vn + vr * VP + vc * 8) = o; } \
        _Pragma("unroll") for (int t = 0; t < 2; ++t) *(LAS u32x2*)(Rt + (16 * t + fr) * TP + 16 * w + 4 * fq) = pack4(racc[t]); \
        LBAR(); \
        if ((s_) + 4 < nch) SC_LOAD(Q_, K_, V_, (s_) + 4); \
        bf16x8 qf[4]; \
        _Pragma("unroll") for (int ks = 0; ks < 4; ++ks) qf[ks] = *(const LAS bf16x8*)(Qn + n * TP + ks * 32 + fq * 8); \
        _Pragma("unroll") for (int t = 0; t < 2; ++t) { f32x4 ca = {0.f, 0.f, 0.f, 0.f}; \
            _Pragma("unroll") for (int ks = 0; ks < 4; ++ks) { const bf16x8 rf = *(const LAS bf16x8*)(Rt + (16 * t + fr) * TP + ks * 32 + fq * 8); ca = MFMA16(rf, qf[ks], ca); } \
            *(u32x2*)(cross + (size_t)(row0 + n) * RW + h * 128 + sl * 32 + 16 * t + 4 * fq) = pack4(ca * xi); } \
        racc[0] = racc[0] * decay; racc[1] = racc[1] * decay; \
        _Pragma("unroll") for (int ks = 0; ks < 4; ++ks) { const bf16x8 kf = tr_frag(Kn, TP, 32 * ks, 16 * w, lane); \
            _Pragma("unroll") for (int t = 0; t < 2; ++t) { const bf16x8 vf = tr_frag(Vn, VP, 32 * ks, 16 * t, lane); racc[t] = MFMA16(kf, vf, racc[t]); } } \
        LBAR(); } while (0)
    SC_LOAD(qA, kA, vA, 0); SC_LOAD(qB, kB, vB, 1); SC_LOAD(qC, kC, vC, 2); SC_LOAD(qD, kD, vD, 3);
    for (int step = 0; step < nch; step += 4) { SC_STEP(qA, kA, vA, step); SC_STEP(qB, kB, vB, step + 1); SC_STEP(qC, kC, vC, step + 2); SC_STEP(qD, kD, vD, step + 3); }
#undef SC_LOAD
#undef SC_STEP
}

DI void sgu_item(LAS unsigned char* lds, int item, const bf16_t* Z, const float* ssqv, const float* normw, const bf16_t* wsb, const float* sgub, bf16_t* MIX) {
    const int tid = threadIdx.x, lane = tid & 63, w = tid >> 6, fr = lane & 15, fq = lane >> 4;
    const int chunk = item >> 3, g = item & 7, row0 = chunk * 128;
    LAS bf16_t* Wsl = (LAS bf16_t*)lds; LAS bf16_t* vt = Wsl + 128 * TP;
    const int tr = tid & 127, tc = tid >> 7;
    u32x4 wv[4], zv[4]; f32x4 nw[4][2];
#pragma unroll
    for (int i = 0; i < 4; ++i) { const int v = tid + 512 * i; wv[i] = *(const u32x4*)(wsb + (size_t)g * 16384 + (size_t)v * 8); }
#pragma unroll
    for (int i = 0; i < 4; ++i) { const int c8 = tc + 4 * i; zv[i] = *(const u32x4*)(Z + (size_t)(row0 + tr) * INC + 5 * 1024 + g * 128 + c8 * 8);
        nw[i][0] = *(const f32x4*)(normw + g * 128 + c8 * 8); nw[i][1] = *(const f32x4*)(normw + g * 128 + c8 * 8 + 4); }
    const f32x4* sp = (const f32x4*)(ssqv + (size_t)(row0 + tr) * 16);
    const float ss = sum4(sp[0]) + sum4(sp[1]) + sum4(sp[2]) + sum4(sp[3]);
    const int n = 16 * w + fr, row = row0 + n;
    const float bn = sgub[g * 128 + n];
    u32x2 uu[8];
#pragma unroll
    for (int db = 0; db < 8; ++db) uu[db] = *(const u32x2*)(Z + (size_t)row * INC + 4 * 1024 + g * 128 + 16 * db + 4 * fq);
    const float rsv = rsqrtf(ss * (1.0f / 1024.f) + EPS);
#pragma unroll
    for (int i = 0; i < 4; ++i) { const int v = tid + 512 * i; *(LAS u32x4*)(Wsl + (v >> 4) * TP + (v & 15) * 8) = wv[i]; }
#pragma unroll
    for (int i = 0; i < 4; ++i) {
        const int c8 = tc + 4 * i;
#pragma unroll
        for (int e = 0; e < 8; e += 2) {
            const unsigned wd = zv[i][e >> 1]; const float s0 = nw[i][e >> 2][e & 3] * rsv, s1 = nw[i][e >> 2][(e + 1) & 3] * rsv;
            const unsigned pk = cvt_pk_bf16(bf_lo(wd) * s0, bf_hi(wd) * s1);
            vt[(c8 * 8 + e) * TP + tr] = (unsigned short)(pk & 0xffffu); vt[(c8 * 8 + e + 1) * TP + tr] = (unsigned short)(pk >> 16);
        }
    }
    LBAR();
    bf16x8 wf[4];
#pragma unroll
    for (int ks = 0; ks < 4; ++ks) wf[ks] = *(const LAS bf16x8*)(Wsl + n * TP + ks * 32 + fq * 8);
#pragma unroll
    for (int db = 0; db < 8; ++db) {
        f32x4 s = {0.f, 0.f, 0.f, 0.f};
#pragma unroll
        for (int ks = 0; ks < 4; ++ks) { const bf16x8 vf = *(const LAS bf16x8*)(vt + (16 * db + fr) * TP + ks * 32 + fq * 8); s = MFMA16(vf, wf[ks], s); }
        const int col = g * 128 + 16 * db + 4 * fq;
        f32x4 o; o[0] = bf_lo(uu[db].x) * (s[0] + bn); o[1] = bf_hi(uu[db].x) * (s[1] + bn); o[2] = bf_lo(uu[db].y) * (s[2] + bn); o[3] = bf_hi(uu[db].y) * (s[3] + bn);
        *(u32x2*)(MIX + (size_t)row * DM + 1024 + col) = pack4(o);
    }
    LBAR();
}

DI void inner_phase(LAS unsigned char* lds, int bid, int G, const bf16_t* Z, const bf16_t* crossF, const bf16_t* crossB, const float* gnw, const float* lgf, const float* lgb, bf16_t* MIX) {
    const int tid = threadIdx.x, lane = tid & 63, w = tid >> 6, fr = lane & 15, fq = lane >> 4;
    LAS bf16_t* Qs = (LAS bf16_t*)lds; LAS bf16_t* Ks = Qs + 128 * TP; LAS bf16_t* Vt = Ks + 128 * TP;
    const int tr = tid & 127, tc = tid >> 7;
    u32x4 qr[4], kr[4], vr[4];
#define IN_LOAD(it_) do { const bf16_t* zb = Z + (size_t)((it_) >> 3) * 128 * INC + ((it_) & 7) * 128; \
        _Pragma("unroll") for (int i = 0; i < 4; ++i) { const int v = tid + 512 * i; const bf16_t* zp = zb + (size_t)(v >> 4) * INC + (v & 15) * 8; qr[i] = *(const u32x4*)zp; kr[i] = *(const u32x4*)(zp + 1024); \
            vr[i] = *(const u32x4*)(zb + (size_t)tr * INC + 2048 + (tc + 4 * i) * 8); } } while (0)
    if (bid < 1024) IN_LOAD(bid);
    for (int item = bid; item < 1024; item += G) {
        const int chunk = item >> 3, h = item & 7, row0 = chunk * 128;
#pragma unroll
        for (int i = 0; i < 4; ++i) { const int v = tid + 512 * i; const int o = (v >> 4) * TP + (v & 15) * 8; *(LAS u32x4*)(Qs + o) = qr[i]; *(LAS u32x4*)(Ks + o) = kr[i];
#pragma unroll
            for (int e = 0; e < 8; ++e) { const int c8 = tc + 4 * i; Vt[(32 * (c8 >> 2) + 16 * (e >> 2) + 4 * (c8 & 3) + (e & 3)) * TP + tr] = u16_of(vr[i], e); } }
        LBAR();
        const float l2f = lgf[h] * LOG2E, l2b = lgb[h] * LOG2E;
        const int n = 16 * w + fr, row = row0 + n;
        u32x4 cf[4], cb[4], gg[4];
#pragma unroll
        for (int a4 = 0; a4 < 4; ++a4) { const int col = h * 128 + 32 * a4 + 8 * fq; cf[a4] = *(const u32x4*)(crossF + (size_t)row * RW + col); cb[a4] = *(const u32x4*)(crossB + (size_t)row * RW + col);
            gg[a4] = *(const u32x4*)(Z + (size_t)row * INC + 3 * 1024 + col); }
        asm volatile("" ::: "memory");
        if (item + G < 1024) IN_LOAD(item + G);
        bf16x8 qf[4];
#pragma unroll
        for (int ks = 0; ks < 4; ++ks) qf[ks] = *(const LAS bf16x8*)(Qs + n * TP + ks * 32 + fq * 8);
        asm volatile("s_waitcnt lgkmcnt(0)" ::: "memory");
#pragma unroll
        for (int mb = 0; mb < 8; ++mb) {
            f32x4 s = {0.f, 0.f, 0.f, 0.f};
#pragma unroll
            for (int ks = 0; ks < 4; ++ks) { const bf16x8 kf = *(const LAS bf16x8*)(Ks + (16 * mb + fr) * TP + ks * 32 + fq * 8); s = MFMA16(kf, qf[ks], s); }
#pragma unroll
            for (int r = 0; r < 4; ++r) { const int d = n - (16 * mb + 4 * fq + r); s[r] *= d >= 0 ? exp2f(l2f * (float)d) : exp2f(l2b * (float)(-d)); }
            *(LAS u32x2*)(Qs + n * TP + 16 * mb + 4 * fq) = pack4(s);
        }
        asm volatile("s_waitcnt lgkmcnt(0)" ::: "memory");
        bf16x8 wf[4];
#pragma unroll
        for (int ks = 0; ks < 4; ++ks) wf[ks] = *(const LAS bf16x8*)(Qs + n * TP + ks * 32 + fq * 8);
        f32x4 o[8]; float sm = 0.f;
#pragma unroll
        for (int eb = 0; eb < 8; ++eb) {
            f32x4 a = {0.f, 0.f, 0.f, 0.f};
#pragma unroll
            for (int ks = 0; ks < 4; ++ks) { const bf16x8 vf = *(const LAS bf16x8*)(Vt + (16 * eb + fr) * TP + ks * 32 + fq * 8); a = MFMA16(vf, wf[ks], a); }
            { const unsigned f0 = cf[eb >> 1][2 * (eb & 1)], f1 = cf[eb >> 1][2 * (eb & 1) + 1], b0 = cb[eb >> 1][2 * (eb & 1)], b1 = cb[eb >> 1][2 * (eb & 1) + 1];
              a[0] += bf_lo(f0) + bf_lo(b0); a[1] += bf_hi(f0) + bf_hi(b0); a[2] += bf_lo(f1) + bf_lo(b1); a[3] += bf_hi(f1) + bf_hi(b1); }
            o[eb] = a; sm += sum4(a);
        }
        sm += __shfl_xor(sm, 16); sm += __shfl_xor(sm, 32);
        const float mean = sm * (1.0f / 128.f); float vs = 0.f;
#pragma unroll
        for (int eb = 0; eb < 8; ++eb) { o[eb] = o[eb] - mean; vs += sq4(o[eb]); }
        vs += __shfl_xor(vs, 16); vs += __shfl_xor(vs, 32);
        const float rstd = rsqrtf(vs * (1.0f / 128.f) + EPS);
#pragma unroll
        for (int a4 = 0; a4 < 4; ++a4) {
            const int col = h * 128 + 32 * a4 + 8 * fq;
            const f32x4 gw0 = *(const f32x4*)(gnw + col), gw1 = *(const f32x4*)(gnw + col + 4);
            const u32x4 g4 = gg[a4]; const f32x4 o0 = o[2 * a4], o1 = o[2 * a4 + 1];
            f32x4 r0, r1;
            r0[0] = bf_lo(g4.x) * (o0[0] * rstd * gw0[0]); r0[1] = bf_hi(g4.x) * (o0[1] * rstd * gw0[1]); r0[2] = bf_lo(g4.y) * (o0[2] * rstd * gw0[2]); r0[3] = bf_hi(g4.y) * (o0[3] * rstd * gw0[3]);
            r1[0] = bf_lo(g4.z) * (o1[0] * rstd * gw1[0]); r1[1] = bf_hi(g4.z) * (o1[1] * rstd * gw1[1]); r1[2] = bf_lo(g4.w) * (o1[2] * rstd * gw1[2]); r1[3] = bf_hi(g4.w) * (o1[3] * rstd * gw1[3]);
            u32x4 w4; w4.x = cvt_pk_bf16(r0[0], r0[1]); w4.y = cvt_pk_bf16(r0[2], r0[3]); w4.z = cvt_pk_bf16(r1[0], r1[1]); w4.w = cvt_pk_bf16(r1[2], r1[3]);
            *(u32x4*)(MIX + (size_t)row * DM + col) = w4;
        }
        LBAR();
    }
#undef IN_LOAD
}

struct Args { const float* in[17]; float* out; unsigned char* ws; };

#define XB_TMO      128
#define XB_XCNT(j)  (256  + 64 * (j))
#define XB_XSUB(j)  (1280 + 64 * (j))
#define XB_XGEN(j)  (2304 + 64 * (j))
#define XB_TOP      3328
#define XB_TOPGEN   3392
#define XCD_BAR_WORDS 3456
#define XB_SPIN_CAP (1u << 18)

__device__ __forceinline__ unsigned xb_ld(unsigned* p)              { return __hip_atomic_load(p, __ATOMIC_RELAXED, __HIP_MEMORY_SCOPE_AGENT); }
__device__ __forceinline__ unsigned xb_add(unsigned* p, unsigned v) { return __hip_atomic_fetch_add(p, v, __ATOMIC_RELAXED, __HIP_MEMORY_SCOPE_AGENT); }
__device__ __forceinline__ unsigned xb_xcc_id() { return (unsigned)__builtin_amdgcn_s_getreg((3 << 11) | 20) & 0xFu; }
#define XB_SPIN(cond, bar) do { unsigned _sp = 0; while (cond) { __builtin_amdgcn_s_sleep(1); \
    if ((++_sp & 255u) == 0u) { if (xb_ld(&(bar)[XB_TMO])) break; if (_sp > XB_SPIN_CAP) { atomicAdd(&(bar)[XB_TMO], 1u); break; } } } } while (0)

struct XcdBarrier {
    unsigned* bar; unsigned x;
    volatile LAS unsigned* st;
};

__device__ __forceinline__ XcdBarrier xcd_barrier_post(unsigned* bar, volatile LAS unsigned* st) {
    XcdBarrier b; b.bar = bar; b.x = xb_xcc_id(); b.st = st;
    if (threadIdx.x == 0) (void)xb_add(&bar[XB_XCNT(b.x)], 1u);
    return b;
}
__device__ __forceinline__ void xcd_barrier_complete(unsigned* bar, unsigned x, unsigned& nloc, unsigned& nx) {
    const unsigned G = gridDim.x * gridDim.y * gridDim.z;
    unsigned sum, cnt, mine, sp = 0u;
    for (;;) {
        sum = 0u; cnt = 0u; mine = 0u;
#pragma unroll
        for (unsigned j = 0; j < 16; ++j) { const unsigned c = xb_ld(&bar[XB_XCNT(j)]); sum += c; cnt += (c > 0u) ? 1u : 0u; mine = (j == x) ? c : mine; }
        if (sum == G) break;
        __builtin_amdgcn_s_sleep(1);
        if ((++sp & 255u) == 0u) { if (xb_ld(&bar[XB_TMO])) break; if (sp > XB_SPIN_CAP) { atomicAdd(&bar[XB_TMO], 1u); break; } }
    }
    nloc = mine > 0u ? mine : 1u; nx = cnt > 0u ? cnt : 1u;
}

__device__ __forceinline__ void xcd_barrier(const XcdBarrier& b) {
    asm volatile("s_waitcnt vmcnt(0)" ::: "memory");
    __syncthreads();
    if (threadIdx.x == 0) {
        unsigned* bar = b.bar;
        __builtin_amdgcn_s_waitcnt(0);
        unsigned nloc = b.st[0], nx = b.st[1];
        if (nloc == 0u) { xcd_barrier_complete(bar, b.x, nloc, nx); b.st[0] = nloc; b.st[1] = nx; }
        const unsigned old = xb_add(&bar[XB_XSUB(b.x)], 1u);
        const unsigned gen = old / nloc;
        if (old + 1u == (gen + 1u) * nloc) {
            __builtin_amdgcn_fence(__ATOMIC_RELEASE, "agent");
            asm volatile("s_waitcnt vmcnt(0)" ::: "memory");
            const unsigned og = xb_add(&bar[XB_TOP], 1u);
            const unsigned tg = og / nx;
            if (og + 1u == (tg + 1u) * nx) xb_add(&bar[XB_TOPGEN], 1u);
            else XB_SPIN(xb_ld(&bar[XB_TOPGEN]) == tg, bar);
            __builtin_amdgcn_fence(__ATOMIC_ACQUIRE, "agent");
            xb_add(&bar[XB_XGEN(b.x)], 1u);
            asm volatile("s_waitcnt vmcnt(0)" ::: "memory");
        } else {
            XB_SPIN(xb_ld(&bar[XB_XGEN(b.x)]) == gen, bar);
            __builtin_amdgcn_fence(__ATOMIC_ACQUIRE, "agent");
            asm volatile("s_waitcnt vmcnt(0)" ::: "memory");
        }
    }
    __syncthreads();
}

#if REP_MASK
#define STAMP(k) do { if (blockIdx.x == 0 && threadIdx.x == 0) ((volatile LAS unsigned*)(lds + MISC_OFF + 64))[k] = (unsigned)__builtin_amdgcn_s_memrealtime(); } while (0)
#else
#define STAMP(k) do { } while (0)
#endif
__global__ void __launch_bounds__(512, 2) fwd_kernel(Args a) {
    extern __shared__ __attribute__((aligned(16))) unsigned char lds_raw[];
    LAS unsigned char* lds = (LAS unsigned char*)lds_raw;
    const int tid = threadIdx.x, lane = tid & 63, wave = __builtin_amdgcn_readfirstlane(tid >> 6);
    const int G = gridDim.x, bid = blockIdx.x;
    unsigned char* ws = a.ws;
    const float* xp = a.in[0]; const float* xs = a.in[1];
    bf16_t* Win_t = (bf16_t*)(ws + WS_WIN); bf16_t* Wout_t = (bf16_t*)(ws + WS_WOUT); bf16_t* Wup_t = (bf16_t*)(ws + WS_WUP); bf16_t* Wdown_t = (bf16_t*)(ws + WS_WDOWN);
    bf16_t* Zb = (bf16_t*)(ws + WS_Z); bf16_t* X1B = (bf16_t*)(ws + WS_X1B); bf16_t* ACT = (bf16_t*)(ws + WS_ACT); bf16_t* MIX = (bf16_t*)(ws + WS_MIX);
    float* HALO = (float*)(ws + WS_HALO); float* ROPE = (float*)(ws + WS_ROPE); float* RS1 = (float*)(ws + WS_RS1);
    float* SSQV = (float*)(ws + WS_SSQV); float* SSQ2 = (float*)(ws + WS_SSQ2); float* SSQ3 = (float*)(ws + WS_SSQ3);
    unsigned* CTL = (unsigned*)(ws + WS_CTL);
    bf16_t* X2B = (bf16_t*)(ws + WS_X1B);
    bf16_t* WSB = (bf16_t*)(ws + 335 * MiB);
    { volatile LAS unsigned* st_ = (volatile LAS unsigned*)(lds + MISC_OFF + 128); if (tid == 0) { st_[0] = 0u; st_[1] = 0u; } }
    __syncthreads();
    const XcdBarrier xbar = xcd_barrier_post(CTL + 1024, (volatile LAS unsigned*)(lds + MISC_OFF + 128));
    bf16_t* XB = (bf16_t*)a.out; bf16_t* crossF = (bf16_t*)a.out + (size_t)T * DM; bf16_t* crossB = crossF + (size_t)T * RW; float* X1 = a.out;

    STAMP(0);
    if (PH_MASK & 1) {
        LAS float* scr = (LAS float*)(lds + wave * 17408);
        const int gw = bid * 8 + wave, NGW = G * 8;
        for (int it = gw; it < (DM / 128) * (INC / 64); it += NGW) tr_pair<true>(a.in[3], DM, INC, Win_t, a.in[2], 1, scr, 2 * (it / (INC / 64)), it % (INC / 64), lane);
        for (int row = gw; row < T; row += 2 * NGW) {
            const int row2 = row + NGW;
            const float* xr = row < 8192 ? xp + (size_t)row * DM : xs + (size_t)(row - 8192) * DM;
            const float* xr2 = row2 < 8192 ? xp + (size_t)row2 * DM : xs + (size_t)(row2 - 8192) * DM;
            f32x4 v[8], u[8]; float s = 0.f, s2 = 0.f;
#pragma unroll
            for (int j = 0; j < 8; ++j) v[j] = __builtin_nontemporal_load((const f32x4*)(xr + 256 * j + 4 * lane));
#pragma unroll
            for (int j = 0; j < 8; ++j) u[j] = __builtin_nontemporal_load((const f32x4*)(xr2 + 256 * j + 4 * lane));
#pragma unroll
            for (int j = 0; j < 8; ++j) { s += sq4(v[j]); s2 += sq4(u[j]); }
            s = wave_sum(s); s2 = wave_sum(s2);
            if (lane == 0) { RS1[row] = rsqrtf(s * (1.0f / DM) + EPS); RS1[row2] = rsqrtf(s2 * (1.0f / DM) + EPS); }
#pragma unroll
            for (int j = 0; j < 8; ++j) { *(u32x2*)(XB + (size_t)row * DM + 256 * j + 4 * lane) = pack4(v[j]); *(u32x2*)(XB + (size_t)row2 * DM + 256 * j + 4 * lane) = pack4(u[j]); }
        }
        for (int e = bid * 512 + tid; e < 8 * 128 * 128 / 4; e += G * 512) *(u32x2*)(WSB + 4 * (size_t)e) = pack4(*(const f32x4*)(a.in[8] + 4 * (size_t)e));
        const float inv = (float)exp2(-(double)(tid & 63) * (13.287712379549449 / 64.0));
        for (int e = bid * 512 + tid; e < 8192 * 64; e += G * 512) {
            const int pos = e >> 6;
            const float ang = (float)pos * inv;
            double rev = (double)ang * 0.15915494309189535; rev -= floor(rev);
            const float fr_ = (float)rev;
            ROPE[2 * e] = __builtin_amdgcn_cosf(fr_); ROPE[2 * e + 1] = __builtin_amdgcn_sinf(fr_);
        }
    }
    xcd_barrier(xbar); STAMP(1);

    if (PH_MASK & 2) {
        pg8::Gemm g{XB, Win_t, T, INC, DM}; pg8::StaticOrder S; S.init(T, INC, G, bid);
        EpiIn E{Zb, RS1, ROPE, SSQV};
        pg8::gemm_phase<EpiIn, pg8::StaticOrder, true, true>(lds, g, S, E);
    }
    xcd_barrier(xbar); STAMP(2);

    if (PH_MASK & 4) {
        volatile LAS int* sh = (volatile LAS int*)(lds + MISC_OFF);
        int pending = -1;
        if (bid < 192) { const int x_ = bid & 7, j_ = bid >> 3, grp_ = j_ >> 2; pending = (grp_ >> 1) * 64 + x_ * 8 + (grp_ & 1) * 4 + (j_ & 3); }
        for (;;) {
            if (pending < 0) {
                if (tid == 0) sh[0] = 192 + (int)atomicAdd(CTL, 1u);
                __syncthreads();
                pending = sh[0];
                __syncthreads();
            }
            const int item = pending; pending = -1;
            if (item >= 192 + 1024 + TR_ITEMS) break;
            if (item < 192) scan_item(lds, item, Zb, crossF, crossB, a.in[4], a.in[5]);
            else if (item >= 192 + TR_ITEMS) sgu_item(lds, item - (192 + TR_ITEMS), Zb, SSQV, a.in[7], WSB, a.in[9], MIX);
            else {
                int r = item - 192; LAS float* scr = (LAS float*)(lds + wave * 17408);
                int lane_ = lane; asm volatile("" : "+v"(lane_));
                if (r < TR_OUT) tr_pair<false>(a.in[10], DM, DM, Wout_t, nullptr, 0, scr, 2 * (r >> 2), (r & 3) * 8 + wave, lane_);
                else if ((r -= TR_OUT) < TR_UP) tr_pair<true>(a.in[12], DM, FF2, Wup_t, a.in[11], 2, scr, 2 * (r / 22), (r % 22) * 8 + wave, lane_);
                else { r -= TR_UP; tr_pair<false>(a.in[15], FF, DM, Wdown_t, nullptr, 0, scr, 2 * (r >> 2), (r & 3) * 8 + wave, lane_); }
            }
        }
    }
    xcd_barrier(xbar); STAMP(3);

    if (PH_MASK & 8) inner_phase(lds, bid, G, Zb, crossF, crossB, a.in[6], a.in[4], a.in[5], MIX);
    xcd_barrier(xbar); STAMP(4);

    if (PH_MASK & 16) {
        pg8::Gemm g{MIX, Wout_t, T, DM, DM}; pg8::StaticOrder S; S.init(T, DM, G, bid);
        EpiRes<false> E{(const float*)XB, nullptr, X1, X1B, SSQ2};
        pg8::gemm_phase<EpiRes<false>, pg8::StaticOrder, true, true>(lds, g, S, E);
    }
    xcd_barrier(xbar); STAMP(5);

    if (PH_MASK & 32) {
        pg8::Gemm g{X1B, Wup_t, T, FF2, DM}; pg8::StaticOrder S; S.init(T, FF2, G, bid);
        EpiUp E{ACT, HALO, SSQ2, a.in[13], a.in[14], (LAS float*)(lds + EX_OFF)};
        pg8::gemm_phase<EpiUp, pg8::StaticOrder, true, true>(lds, g, S, E);
    }
    xcd_barrier(xbar); STAMP(6);

    if (PH_MASK & 64) {
        const float* cw = a.in[13]; const float* cb = a.in[14];
        for (int e = bid * 512 + tid; e < 128 * FF; e += G * 512) {
            const int idx = e / FF, c = e - idx * FF, p = idx >> 1, which = idx & 1;
            const int row = p * 256 + (which ? 255 : 0);
            const bool first = (row == 0) || (row == 4096) || (row == 8192), last = (row == 4095) || (row == 8191) || (row == 16383);
            const int pa = 256 * (c >> 7) + (c & 127), pb = pa + 128;
            const float* hp = HALO + (size_t)(p * 4) * FF2;
            float pra, prb, cua, cub, nxa, nxb;
            if (which == 0) {
                pra = first ? 0.f : hp[-(ptrdiff_t)FF2 + pa]; prb = first ? 0.f : hp[-(ptrdiff_t)FF2 + pb];
                cua = hp[pa]; cub = hp[pb]; nxa = hp[FF2 + pa]; nxb = hp[FF2 + pb];
            } else {
                pra = hp[2 * FF2 + pa]; prb = hp[2 * FF2 + pb]; cua = hp[3 * FF2 + pa]; cub = hp[3 * FF2 + pb];
                nxa = last ? 0.f : hp[4 * (size_t)FF2 + pa]; nxb = last ? 0.f : hp[4 * (size_t)FF2 + pb];
            }
            const float va = cw[c] * pra + cw[FF2 + c] * cua + cw[2 * FF2 + c] * nxa + cb[c];
            const float vb = cw[FF + c] * prb + cw[FF2 + FF + c] * cub + cw[2 * FF2 + FF + c] * nxb + cb[FF + c];
            ACT[(size_t)row * FF + c] = (bf16_t)(cvt_pk_bf16(silu_f(va) * vb, 0.f) & 0xffffu);
        }
    }
    xcd_barrier(xbar); STAMP(7);

    if (PH_MASK & 128) {
        pg8::Gemm g{ACT, Wdown_t, T, DM, FF}; pg8::StaticOrder S; S.init(T, DM, G, bid);
        EpiRes<true> E{nullptr, nullptr, (float*)X2B, X1B, SSQ3};
        pg8::gemm_phase<EpiRes<true>, pg8::StaticOrder, true, true>(lds, g, S, E);
    }
    xcd_barrier(xbar); STAMP(8);

    if (PH_MASK & 256) {
        const int gw = bid * 8 + wave, NGW = G * 8; const float* fw = a.in[16];
        for (int row = gw; row < T; row += NGW) {
            float s = lane < 32 ? SSQ3[(size_t)row * 32 + lane] : 0.f;
            s = wave_sum(s);
            const float rs = rsqrtf(s * (1.0f / DM) + EPS);
            float* orow = a.out + (size_t)row * DM; const bf16_t* xrow = X2B + (size_t)row * DM;
#pragma unroll
            for (int j = 0; j < 4; ++j) { const u32x4 xb = *(const u32x4*)(xrow + 512 * j + 8 * lane); const f32x4 w0 = *(const f32x4*)(fw + 512 * j + 8 * lane), w1 = *(const f32x4*)(fw + 512 * j + 8 * lane + 4);
                f32x4 o0, o1; o0[0] = bf_lo(xb.x) * rs * w0[0]; o0[1] = bf_hi(xb.x) * rs * w0[1]; o0[2] = bf_lo(xb.y) * rs * w0[2]; o0[3] = bf_hi(xb.y) * rs * w0[3];
                o1[0] = bf_lo(xb.z) * rs * w1[0]; o1[1] = bf_hi(xb.z) * rs * w1[1]; o1[2] = bf_lo(xb.w) * rs * w1[2]; o1[3] = bf_hi(xb.w) * rs * w1[3];
                __builtin_nontemporal_store(o0, (f32x4*)(orow + 512 * j + 8 * lane)); __builtin_nontemporal_store(o1, (f32x4*)(orow + 512 * j + 8 * lane + 4)); }
        }
    }
#if REP_MASK
    STAMP(9);
    if (blockIdx.x == 0 && threadIdx.x == 0) {
        volatile LAS unsigned* tsv = (volatile LAS unsigned*)(lds + MISC_OFF + 64);
        unsigned dt = 0;
#pragma unroll
        for (int k = 0; k < 9; ++k) if ((REP_MASK >> k) & 1) dt += tsv[k + 1] - tsv[k];
        const unsigned t0 = (unsigned)__builtin_amdgcn_s_memrealtime();
        while ((unsigned)__builtin_amdgcn_s_memrealtime() - t0 < dt) __builtin_amdgcn_s_sleep(8);
    }
#endif
}

extern "C" void kernel_launch(void* const* d_in, const int* in_sizes, int n_in, void* d_out, int out_size, void* d_ws, size_t ws_size, hipStream_t stream) {
    static int grid = 0;
    if (grid == 0) {
        if (n_in != 17 || out_size != 2 * T / 2 * DM || ws_size < WS_END) { fprintf(stderr, "kernel_launch: unexpected sizes n_in %d out %d ws %zu (need %zu)\n", n_in, out_size, ws_size, (size_t)WS_END); grid = -1; }
        else {
            int dev = 0, cus = 0, per_cu = 0;
            (void)hipGetDevice(&dev); (void)hipDeviceGetAttribute(&cus, hipDeviceAttributeMultiprocessorCount, dev);
            (void)hipFuncSetAttribute((const void*)fwd_kernel, hipFuncAttributeMaxDynamicSharedMemorySize, LDS_BYTES);
            (void)hipOccupancyMaxActiveBlocksPerMultiprocessor(&per_cu, (const void*)fwd_kernel, 512, LDS_BYTES);
            if (per_cu < 1 || cus < 1) { fprintf(stderr, "kernel_launch: occupancy query says %d blocks/CU on %d CUs\n", per_cu, cus); grid = -1; }
            else grid = cus;
        }
    }
    if (grid < 0) { (void)hipMemsetAsync(d_out, 0, (size_t)out_size * 4, stream); return; }
    (void)hipMemsetAsync((char*)d_ws + WS_CTL, 0, 65536, stream);
    Args a{};
    for (int i = 0; i < 17; ++i) a.in[i] = (const float*)d_in[i];
    a.out = (float*)d_out; a.ws = (unsigned char*)d_ws;
    void* kargs[] = {&a};
    const hipError_t e = hipLaunchCooperativeKernel((const void*)fwd_kernel, dim3(grid), dim3(512), kargs, LDS_BYTES, stream);
    if (e != hipSuccess) fprintf(stderr, "kernel_launch: cooperative launch failed: %s (grid %d)\n", hipGetErrorString(e), grid);
}
```

```cpp
#include <hip/hip_runtime.h>
#include <hip/hip_cooperative_groups.h>
#include <cstdio>
#include <cstdint>
namespace cg = cooperative_groups;
namespace pg8 {
#define PG8_LAS __attribute__((address_space(3)))
typedef unsigned short bf16_t;
typedef short bf16x8 __attribute__((ext_vector_type(8)));
typedef float f32x4 __attribute__((ext_vector_type(4)));
typedef unsigned u32x4 __attribute__((ext_vector_type(4)));
constexpr int BM = 256, BK = 64, HALF = 128, HTB = HALF * BK * 2  , STAGE_BYTES = 8 * HTB, NXCD = 8, WGM = 8;

__host__ __device__ __forceinline__ int lds_byte(int r, int c) { const int st = (r >> 4) * 2 + (c >> 5), rr = r & 15, cc = c & 31, ob = rr * 64 + cc * 2; return st * 1024 + (ob ^ (((ob >> 9) & 1) << 5)); }
__host__ __device__ __forceinline__ void stage_rc(int b, int& R, int& C) { const int st = b / 1024, sb = b % 1024, swz = sb ^ (((sb >> 9) & 1) << 5); R = (st >> 1) * 16 + swz / 64; C = (st & 1) * 32 + (swz % 64) / 2; }
__host__ __device__ __forceinline__ int perm32(int rho) { const int n = rho >> 4, i = rho & 15; return 8 * (i >> 2) + 4 * n + (i & 3); }

struct Unit { int pm, pn; };
struct Gemm { const bf16_t* A; const bf16_t* Bt; int M, N, K; };

struct StaticOrder {
    int nM, nN, nwg, G, c;
    __host__ __device__ void init(int M, int N, int G_, int c_) { nM = M / BM; nN = N / BM; nwg = nM * nN; G = G_; c = c_; }
    __host__ __device__ bool next(int i, Unit& u) const {
        const long L = (long)i * G + c; if (L >= nwg) return false;
        int wgid = (int)L; { const int q = nwg / NXCD, r = nwg % NXCD, xcd = wgid % NXCD, off = wgid / NXCD; wgid = (xcd < r ? xcd * (q + 1) : r * (q + 1) + (xcd - r) * q) + off; }
        const int nig = WGM * nN, gid = wgid / nig, fm = gid * WGM, gsz = (nM - fm) < WGM ? (nM - fm) : WGM;
        u.pm = fm + ((wgid % nig) % gsz); u.pn = (wgid % nig) / gsz; return true;
    }
    __device__ __forceinline__ void a_ready(const Unit&) const {}
    __device__ __forceinline__ void done(const Unit&) const {}
};

__device__ __forceinline__ unsigned cvt_pk_bf16(float lo, float hi) { unsigned r; asm volatile("v_cvt_pk_bf16_f32 %0, %1, %2" : "=v"(r) : "v"(lo), "v"(hi)); return r; }
template <class Epi, class Sched, bool ALIGN_EPI = false, bool SP2 = false>
__device__ __forceinline__ void gemm_phase(PG8_LAS unsigned char* lds, const Gemm g, const Sched& S, const Epi& E) {
    int tid_ = threadIdx.x; asm volatile("" : "+v"(tid_));
    const int tid = tid_, wid = __builtin_amdgcn_readfirstlane(tid >> 6), lane = tid & 63, wr = wid >> 2, wc = wid & 3, fr = lane & 15, fq = lane >> 4;
    const int K = g.K, nt = K / BK;
    unsigned voffA[2], voffB[2];
#pragma unroll
    for (int i = 0; i < 2; ++i) { int R, C; stage_rc(tid * 16 + i * 8192, R, C); const int Rb = Epi::PERM ? ((R & ~31) + perm32(R & 31)) : R;
        const int Ra = Epi::PERMA ? ((R & 64) + 4 * (R & 15) + ((R >> 4) & 3)) : R; voffA[i] = (unsigned)(Ra * K + C) * 2u; voffB[i] = (unsigned)(Rb * K + C) * 2u; }
    const size_t kstep = (size_t)(BK * 2);
    const size_t hstep = (size_t)HALF * K * 2;
    const size_t tstep = 2 * hstep;
    const unsigned ldsw = (unsigned)wid * 1024u;
    const int aoff = lds_byte(wr * 64 + fr, fq * 8), boff = lds_byte(wc * 32 + fr, fq * 8);
#define PG8_SA(b, h) (((b) * 2 + (h)) * HTB)
#define PG8_SB(b, h) ((4 + (b) * 2 + (h)) * HTB)
#define PG8_STAGE(bufoff, gbase, voff) do { _Pragma("unroll") for (int _i = 0; _i < 2; ++_i) \
        __builtin_amdgcn_global_load_lds((const unsigned*)((const char*)(gbase) + (voff)[_i]), (PG8_LAS unsigned*)(lds + (bufoff) + ldsw + _i * 8192), 16, 0, 0); } while (0)
#define PG8_LDA(dst, b, h) do { _Pragma("unroll") for (int m = 0; m < 4; ++m) _Pragma("unroll") for (int k = 0; k < 2; ++k) dst[m][k] = *(const PG8_LAS bf16x8*)(lds + PG8_SA(b, h) + aoff + m * 2048 + k * 1024); } while (0)
#define PG8_LDB(dst, b, h) do { _Pragma("unroll") for (int n = 0; n < 2; ++n) _Pragma("unroll") for (int k = 0; k < 2; ++k) dst[n][k] = *(const PG8_LAS bf16x8*)(lds + PG8_SB(b, h) + boff + n * 2048 + k * 1024); } while (0)
#define PG8_MMA(ai, bj, At, Bt) do { __builtin_amdgcn_s_setprio(1); _Pragma("unroll") for (int m = 0; m < 4; ++m) _Pragma("unroll") for (int n = 0; n < 2; ++n) _Pragma("unroll") for (int k = 0; k < 2; ++k) \
        acc[ai][bj][m][n] = __builtin_amdgcn_mfma_f32_16x16x32_bf16(Bt[n][k], At[m][k], acc[ai][bj][m][n], 0, 0, 0); __builtin_amdgcn_s_setprio(0); } while (0)
#define PG8_WAIT_V(n) asm volatile("s_waitcnt vmcnt(" #n ")" ::: "memory")
#define PG8_WAIT_L(n) asm volatile("s_waitcnt lgkmcnt(" #n ")" ::: "memory")
#define PG8_BAR __builtin_amdgcn_s_barrier()
#define PG8_SCHED __builtin_amdgcn_sched_barrier(0)
    Unit cur, nxt; int ui = 0;
    if (!S.next(0, cur)) return;
    f32x4 acc[2][2][4][2];
#pragma unroll
    for (int a = 0; a < 2; ++a)
#pragma unroll
        for (int b = 0; b < 2; ++b)
#pragma unroll
            for (int m = 0; m < 4; ++m)
#pragma unroll
                for (int n = 0; n < 2; ++n) acc[a][b][m][n] = (f32x4){0.f, 0.f, 0.f, 0.f};
    bf16x8 At[4][2], B0[2][2], B1[2][2];
    const char* cA = (const char*)g.A + (size_t)cur.pm * tstep; const char* cB = (const char*)g.Bt + (size_t)cur.pn * tstep;
    S.a_ready(cur);
    if constexpr (SP2) {
        PG8_STAGE(PG8_SB(0, 0), cB, voffB); PG8_STAGE(PG8_SB(0, 1), cB + hstep, voffB); PG8_STAGE(PG8_SA(0, 0), cA, voffA); PG8_STAGE(PG8_SA(0, 1), cA + hstep, voffA);
        if (wr == 1) PG8_BAR;
        PG8_WAIT_V(2); PG8_BAR;
        PG8_STAGE(PG8_SB(1, 0), cB + kstep, voffB); PG8_STAGE(PG8_SA(1, 0), cA + kstep, voffA); PG8_STAGE(PG8_SB(1, 1), cB + hstep + kstep, voffB);
        PG8_WAIT_V(6); PG8_BAR;
    } else {
        PG8_STAGE(PG8_SB(0, 0), cB, voffB); PG8_STAGE(PG8_SA(0, 0), cA, voffA); PG8_STAGE(PG8_SB(0, 1), cB + hstep, voffB); PG8_STAGE(PG8_SA(0, 1), cA + hstep, voffA);
        if (wr == 1) PG8_BAR;
        PG8_WAIT_V(4); PG8_BAR;
        PG8_STAGE(PG8_SB(1, 0), cB + kstep, voffB); PG8_STAGE(PG8_SA(1, 0), cA + kstep, voffA); PG8_STAGE(PG8_SB(1, 1), cB + hstep + kstep, voffB);
        PG8_WAIT_V(6); PG8_BAR;
    }
    for (;;) {
        const bool has_next = S.next(ui + 1, nxt);
        const char* nA = has_next ? (const char*)g.A + (size_t)nxt.pm * tstep : cA; const char* nB = has_next ? (const char*)g.Bt + (size_t)nxt.pn * tstep : cB;
        for (int t = 0; t < nt; t += 2) {
            const bool last = (t == nt - 2);
            const char* a1 = cA + (size_t)(t + 1) * kstep;
            const char* a2 = last ? nA : cA + (size_t)(t + 2) * kstep; const char* b2 = last ? nB : cB + (size_t)(t + 2) * kstep;
            const char* a3 = a2 + kstep; const char* b3 = b2 + kstep;
            if (last && has_next) S.a_ready(nxt);
            if constexpr (SP2) {
            PG8_LDB(B0, 0, 0); PG8_LDB(B1, 0, 1); PG8_SCHED; PG8_LDA(At, 0, 0); PG8_STAGE(PG8_SA(1, 1), a1 + hstep, voffA);
            PG8_WAIT_V(8); PG8_WAIT_L(0); PG8_BAR; PG8_MMA(0, 0, At, B0); PG8_MMA(0, 1, At, B1); PG8_BAR; PG8_SCHED;
            PG8_LDA(At, 0, 1); PG8_STAGE(PG8_SB(0, 0), b2, voffB); PG8_STAGE(PG8_SB(0, 1), b2 + hstep, voffB); PG8_STAGE(PG8_SA(0, 0), a2, voffA);
            PG8_WAIT_V(8); PG8_WAIT_L(0); PG8_BAR; PG8_MMA(1, 0, At, B0); PG8_MMA(1, 1, At, B1); PG8_BAR; PG8_SCHED;
            PG8_LDB(B0, 1, 0); PG8_LDB(B1, 1, 1); PG8_SCHED; PG8_LDA(At, 1, 0); PG8_STAGE(PG8_SA(0, 1), a2 + hstep, voffA);
            PG8_WAIT_V(8); PG8_WAIT_L(0); PG8_BAR; PG8_MMA(0, 0, At, B0); PG8_MMA(0, 1, At, B1); PG8_BAR; PG8_SCHED;
            PG8_LDA(At, 1, 1); PG8_STAGE(PG8_SB(1, 0), b3, voffB); PG8_STAGE(PG8_SB(1, 1), b3 + hstep, voffB); PG8_STAGE(PG8_SA(1, 0), a3, voffA);
            PG8_WAIT_V(8); PG8_WAIT_L(0); PG8_BAR; PG8_MMA(1, 0, At, B0); PG8_MMA(1, 1, At, B1); PG8_BAR; PG8_SCHED;
            } else {
            PG8_LDB(B0, 0, 0); PG8_SCHED; PG8_LDA(At, 0, 0); PG8_STAGE(PG8_SA(1, 1), a1 + hstep, voffA);
            PG8_WAIT_L(8); PG8_BAR; PG8_WAIT_L(0); PG8_MMA(0, 0, At, B0); PG8_BAR; PG8_SCHED;
            PG8_LDB(B1, 0, 1); PG8_STAGE(PG8_SB(0, 0), b2, voffB);
            PG8_BAR; PG8_WAIT_L(0); PG8_MMA(0, 1, At, B1); PG8_BAR;
            PG8_LDA(At, 0, 1); PG8_STAGE(PG8_SA(0, 0), a2, voffA);
            PG8_BAR; PG8_WAIT_L(0); PG8_MMA(1, 0, At, B0); PG8_BAR; PG8_SCHED;
            PG8_STAGE(PG8_SB(0, 1), b2 + hstep, voffB);
            PG8_WAIT_V(6); PG8_BAR; PG8_MMA(1, 1, At, B1); PG8_BAR;
            PG8_LDB(B0, 1, 0); PG8_SCHED; PG8_LDA(At, 1, 0); PG8_STAGE(PG8_SA(0, 1), a2 + hstep, voffA);
            PG8_WAIT_L(8); PG8_BAR; PG8_WAIT_L(0); PG8_MMA(0, 0, At, B0); PG8_BAR; PG8_SCHED;
            PG8_LDB(B1, 1, 1); PG8_STAGE(PG8_SB(1, 0), b3, voffB);
            PG8_BAR; PG8_WAIT_L(0); PG8_MMA(0, 1, At, B1); PG8_BAR;
            PG8_LDA(At, 1, 1); PG8_STAGE(PG8_SA(1, 0), a3, voffA);
            PG8_BAR; PG8_WAIT_L(0); PG8_MMA(1, 0, At, B0); PG8_BAR; PG8_SCHED;
            PG8_STAGE(PG8_SB(1, 1), b3 + hstep, voffB);
            PG8_WAIT_V(6); PG8_BAR; PG8_MMA(1, 1, At, B1); PG8_BAR;
            }
        }
        if constexpr (ALIGN_EPI) { if (wr == 0) PG8_BAR; }
        if constexpr (!Epi::AFTER_DRAIN) { E(acc, cur, wr, wc, fr, fq); S.done(cur); }
        if (!has_next) break;
#pragma unroll
        for (int a = 0; a < 2; ++a)
#pragma unroll
            for (int b = 0; b < 2; ++b)
#pragma unroll
                for (int m = 0; m < 4; ++m)
#pragma unroll
                    for (int n = 0; n < 2; ++n) acc[a][b][m][n] = (f32x4){0.f, 0.f, 0.f, 0.f};
        cur = nxt; cA = nA; cB = nB; ++ui;
        if constexpr (ALIGN_EPI) { if (wr == 1) PG8_BAR; }
    }
    PG8_WAIT_V(0);
    if constexpr (!ALIGN_EPI) { if (wr == 0) PG8_BAR; }
    PG8_BAR;
    if constexpr (Epi::AFTER_DRAIN) { E.fused(acc, cur, wr, wc, fr, fq, lds, wid, lane); S.done(cur); }
#undef PG8_SA
#undef PG8_SB
#undef PG8_STAGE
#undef PG8_LDA
#undef PG8_LDB
#undef PG8_MMA
#undef PG8_WAIT_V
#undef PG8_WAIT_L
#undef PG8_BAR
#undef PG8_SCHED
}
}

#ifndef PH_MASK
#define PH_MASK 0x1ff
#endif
#ifndef REP_MASK
#define REP_MASK 0
#endif
#define DI __device__ __forceinline__
#define LAS __attribute__((address_space(3)))
using pg8::bf16_t; using pg8::bf16x8; using pg8::f32x4; using pg8::u32x4; using pg8::cvt_pk_bf16;
typedef unsigned u32x2 __attribute__((ext_vector_type(2)));

constexpr int T = 16384, DM = 2048, INC = 6144, FF = 5632, FF2 = 11264, RW = 1024;
constexpr float EPS = 1e-6f, LOG2E = 1.4426950408889634f;
constexpr size_t MiB = 1u << 20;
constexpr size_t WS_CTL = 0, WS_ROPE = 1 * MiB, WS_WOUT = 5 * MiB, WS_WUP = 13 * MiB, WS_WDOWN = 57 * MiB;
constexpr size_t WS_Z = 79 * MiB;
constexpr size_t WS_X1B = 79 * MiB;
constexpr size_t WS_ACT = 143 * MiB;
constexpr size_t WS_WIN = 271 * MiB;
constexpr size_t WS_MIX = 271 * MiB;
constexpr size_t WS_HALO = 319 * MiB;
constexpr size_t WS_RS1 = 336 * MiB, WS_SSQV = 337 * MiB, WS_SSQ2 = 338 * MiB, WS_SSQ3 = 340 * MiB, WS_END = 342 * MiB;
constexpr int RING_BYTES = 131072, EX_OFF = 131072, MISC_OFF = 139264, LDS_BYTES = 147456;
constexpr int TP = 136;
constexpr int TR_OUT = (DM / 128) * (DM / 512), TR_UP = (DM / 128) * (FF2 / 512), TR_DN = (FF / 128) * (DM / 512), TR_ITEMS = TR_OUT + TR_UP + TR_DN;

DI float silu_f(float x) { return x * __builtin_amdgcn_rcpf(1.f + __builtin_amdgcn_exp2f(-LOG2E * x)); }
DI float gelu_f(float x) { const float u = x + 0.044715f * x * x * x; return x * __builtin_amdgcn_rcpf(1.f + __builtin_amdgcn_exp2f(-2.f * 0.7978845608028654f * LOG2E * u)); }
DI f32x4 silu4(f32x4 x) { const f32x4 t = x * (-LOG2E); f32x4 e; e[0] = __builtin_amdgcn_exp2f(t[0]); e[1] = __builtin_amdgcn_exp2f(t[1]); e[2] = __builtin_amdgcn_exp2f(t[2]); e[3] = __builtin_amdgcn_exp2f(t[3]);
    const f32x4 d = e + 1.0f; f32x4 r; r[0] = __builtin_amdgcn_rcpf(d[0]); r[1] = __builtin_amdgcn_rcpf(d[1]); r[2] = __builtin_amdgcn_rcpf(d[2]); r[3] = __builtin_amdgcn_rcpf(d[3]); return x * r; }
DI f32x4 gelu4(f32x4 x) { const f32x4 u = x * (x * x * 0.044715f + 1.0f); const f32x4 t = u * (-2.f * 0.7978845608028654f * LOG2E);
    f32x4 e; e[0] = __builtin_amdgcn_exp2f(t[0]); e[1] = __builtin_amdgcn_exp2f(t[1]); e[2] = __builtin_amdgcn_exp2f(t[2]); e[3] = __builtin_amdgcn_exp2f(t[3]);
    const f32x4 d = e + 1.0f; f32x4 r; r[0] = __builtin_amdgcn_rcpf(d[0]); r[1] = __builtin_amdgcn_rcpf(d[1]); r[2] = __builtin_amdgcn_rcpf(d[2]); r[3] = __builtin_amdgcn_rcpf(d[3]); return x * r; }
DI float bf_lo(unsigned w) { return __uint_as_float(w << 16); }
DI float bf_hi(unsigned w) { return __uint_as_float(w & 0xffff0000u); }
DI unsigned short u16_of(const u32x4& v, int e) { const unsigned w = v[e >> 1]; return (unsigned short)((e & 1) ? (w >> 16) : (w & 0xffffu)); }
DI u32x2 pack4(const f32x4& v) { u32x2 r; r.x = cvt_pk_bf16(v[0], v[1]); r.y = cvt_pk_bf16(v[2], v[3]); return r; }
DI float sum4(const f32x4& v) { return (v[0] + v[1]) + (v[2] + v[3]); }
DI float sq4(const f32x4& v) { return (v[0] * v[0] + v[1] * v[1]) + (v[2] * v[2] + v[3] * v[3]); }
DI float wave_sum(float v) {
#pragma unroll
    for (int o = 1; o < 64; o <<= 1) v += __shfl_xor(v, o);
    return v;
}
#define LBAR() do { asm volatile("s_waitcnt lgkmcnt(0)" ::: "memory"); __builtin_amdgcn_s_barrier(); asm volatile("" ::: "memory"); } while (0)
#define MFMA16(a, b, c) __builtin_amdgcn_mfma_f32_16x16x32_bf16((a), (b), (c), 0, 0, 0)

struct EpiIn {
    static constexpr bool PERM = true, AFTER_DRAIN = false, PERMA = false;
    bf16_t* Z; const float* rs1; const float* rope; float* ssqv;
    DI void operator()(const f32x4 (&acc)[2][2][4][2], const pg8::Unit& u, int wr, int wc, int fr, int fq) const {
        const int region = u.pn >> 2;
#pragma unroll
        for (int ai = 0; ai < 2; ++ai)
#pragma unroll
            for (int m = 0; m < 4; ++m) {
                const int row = u.pm * 256 + ai * 128 + wr * 64 + m * 16 + fr;
                const float rs = rs1[row];
                bf16_t* zr = Z + (size_t)row * INC;
                if (region < 2) {
                    const int pos = row < 4096 ? row : (row < 8192 ? row - 4096 : row - 8192);
                    const f32x4* rp = (const f32x4*)(rope + ((size_t)pos * 64 + 16 * wc + 4 * fq) * 2);
                    const f32x4 cs0 = rp[0], cs1 = rp[1];
#pragma unroll
                    for (int bj = 0; bj < 2; ++bj) {
                        const f32x4 x1 = acc[ai][bj][m][0] * rs, x2 = acc[ai][bj][m][1] * rs;
                        f32x4 o1, o2;
                        o1[0] = x1[0] * cs0[0] - x2[0] * cs0[1]; o2[0] = x2[0] * cs0[0] + x1[0] * cs0[1];
                        o1[1] = x1[1] * cs0[2] - x2[1] * cs0[3]; o2[1] = x2[1] * cs0[2] + x1[1] * cs0[3];
                        o1[2] = x1[2] * cs1[0] - x2[2] * cs1[1]; o2[2] = x2[2] * cs1[0] + x1[2] * cs1[1];
                        o1[3] = x1[3] * cs1[2] - x2[3] * cs1[3]; o2[3] = x2[3] * cs1[2] + x1[3] * cs1[3];
                        const int col = region * 1024 + ((u.pn & 3) * 2 + bj) * 128 + 16 * wc + 4 * fq;
                        *(u32x2*)(zr + col) = pack4(o1); *(u32x2*)(zr + col + 64) = pack4(o2);
                    }
                } else {
                    float ss = 0.f;
#pragma unroll
                    for (int bj = 0; bj < 2; ++bj) {
                        f32x4 v0 = acc[ai][bj][m][0] * rs, v1 = acc[ai][bj][m][1] * rs;
                        if (region == 3) { v0 = silu4(v0); v1 = silu4(v1); }
                        else if (region >= 4) { v0 = gelu4(v0); v1 = gelu4(v1); }
                        ss += sq4(v0) + sq4(v1);
                        u32x4 w4; w4.x = cvt_pk_bf16(v0[0], v0[1]); w4.y = cvt_pk_bf16(v0[2], v0[3]); w4.z = cvt_pk_bf16(v1[0], v1[1]); w4.w = cvt_pk_bf16(v1[2], v1[3]);
                        *(u32x4*)(zr + u.pn * 256 + bj * 128 + 32 * wc + 8 * fq) = w4;
                    }
                    if (region == 5) { ss += __shfl_xor(ss, 16); ss += __shfl_xor(ss, 32); if (fq == 0) ssqv[(size_t)row * 16 + (u.pn - 20) * 4 + wc] = ss; }
                }
            }
    }
};

template <bool DOWN> struct EpiRes {
    static constexpr bool PERM = true, AFTER_DRAIN = false, PERMA = false;
    const float* xp; const float* xs; float* X1; bf16_t* X1B; float* ssq;
    DI void operator()(const f32x4 (&acc)[2][2][4][2], const pg8::Unit& u, int wr, int wc, int fr, int fq) const {
#pragma unroll
        for (int ai = 0; ai < 2; ++ai)
#pragma unroll
            for (int m = 0; m < 4; ++m) {
                const int row = u.pm * 256 + ai * 128 + wr * 64 + m * 16 + fr;
                float ss = 0.f;
#pragma unroll
                for (int bj = 0; bj < 2; ++bj) {
                    const int col = u.pn * 256 + bj * 128 + 32 * wc + 8 * fq;
                    f32x4 b0, b1;
                    if (DOWN) { const u32x4 xb = *(const u32x4*)(X1B + (size_t)row * DM + col); b0[0] = bf_lo(xb.x); b0[1] = bf_hi(xb.x); b0[2] = bf_lo(xb.y); b0[3] = bf_hi(xb.y); b1[0] = bf_lo(xb.z); b1[1] = bf_hi(xb.z); b1[2] = bf_lo(xb.w); b1[3] = bf_hi(xb.w); }
                    else { const u32x4 xb = *(const u32x4*)((const bf16_t*)xp + (size_t)row * DM + col); b0[0] = bf_lo(xb.x); b0[1] = bf_hi(xb.x); b0[2] = bf_lo(xb.y); b0[3] = bf_hi(xb.y); b1[0] = bf_lo(xb.z); b1[1] = bf_hi(xb.z); b1[2] = bf_lo(xb.w); b1[3] = bf_hi(xb.w); }
                    const f32x4 v0 = acc[ai][bj][m][0] + b0, v1 = acc[ai][bj][m][1] + b1;
                    ss += sq4(v0) + sq4(v1);
                    if (DOWN) { u32x4 w4; w4.x = cvt_pk_bf16(v0[0], v0[1]); w4.y = cvt_pk_bf16(v0[2], v0[3]); w4.z = cvt_pk_bf16(v1[0], v1[1]); w4.w = cvt_pk_bf16(v1[2], v1[3]);
                        *(u32x4*)((bf16_t*)X1 + (size_t)row * DM + col) = w4; }
                    if (!DOWN) { u32x4 w4; w4.x = cvt_pk_bf16(v0[0], v0[1]); w4.y = cvt_pk_bf16(v0[2], v0[3]); w4.z = cvt_pk_bf16(v1[0], v1[1]); w4.w = cvt_pk_bf16(v1[2], v1[3]);
                        *(u32x4*)(X1B + (size_t)row * DM + col) = w4; }
                }
                ss += __shfl_xor(ss, 16); ss += __shfl_xor(ss, 32);
                if (fq == 0) ssq[(size_t)row * 32 + u.pn * 4 + wc] = ss;
            }
    }
};

struct EpiUp {
    static constexpr bool PERM = true, AFTER_DRAIN = false, PERMA = true;
    bf16_t* ACT; float* HALO; const float* ssq2; const float* convw; const float* convb; LAS float* ex;
    DI void operator()(const f32x4 (&acc)[2][2][4][2], const pg8::Unit& u, int wr, int wc, int fr, int fq) const {
        asm volatile("" : "+v"(fr), "+v"(fq));
        asm volatile("" : "+s"(wr), "+s"(wc));
        const int lane = fq * 16 + fr;
        const int tcol = 32 * wc + 8 * fq;
        float rs[2][4];
#pragma unroll
        for (int ai = 0; ai < 2; ++ai) {
#pragma unroll
            for (int m = 0; m < 4; ++m) {
                const int row = u.pm * 256 + ai * 128 + wr * 64 + 4 * fr + m;
                const f32x4* p = (const f32x4*)(ssq2 + (size_t)row * 32 + fq * 8);
                float s = sum4(p[0]) + sum4(p[1]);
                s += __shfl_xor(s, 16); s += __shfl_xor(s, 32);
                rs[ai][m] = rsqrtf(s * (1.0f / DM) + EPS);
            }
            const int b = 2 * ai + wr;
            if (fr == 0 || fr == 15) {
                const bool lo = fr == 0;
#pragma unroll
                for (int bj = 0; bj < 2; ++bj)
#pragma unroll
                    for (int n = 0; n < 2; ++n) {
                        const f32x4 a0 = acc[ai][bj][0][n] * rs[ai][0], a3 = acc[ai][bj][3][n] * rs[ai][3];
                        f32x4 val; val[0] = lo ? a0[0] : a3[0]; val[1] = lo ? a0[1] : a3[1]; val[2] = lo ? a0[2] : a3[2]; val[3] = lo ? a0[3] : a3[3];
                        *(LAS f32x4*)(ex + (b * 2 + (lo ? 0 : 1)) * 256 + bj * 128 + tcol + 4 * n) = val;
                    }
            }
        }
        {
            const bool hfirst = (wr == 0 && fr == 0), hlast = (wr == 1 && fr == 15);
            if (hfirst || hlast) {
#pragma unroll
                for (int k = 0; k < 2; ++k)
#pragma unroll
                    for (int bj = 0; bj < 2; ++bj)
#pragma unroll
                        for (int n = 0; n < 2; ++n) {
                            const f32x4 a0 = acc[0][bj][k][n] * rs[0][k], a1 = acc[1][bj][2 + k][n] * rs[1][2 + k];
                            f32x4 val; val[0] = hfirst ? a0[0] : a1[0]; val[1] = hfirst ? a0[1] : a1[1]; val[2] = hfirst ? a0[2] : a1[2]; val[3] = hfirst ? a0[3] : a1[3];
                            *(f32x4*)(HALO + (size_t)(u.pm * 4 + (hfirst ? k : 2 + k)) * FF2 + u.pn * 256 + bj * 128 + tcol + 4 * n) = val;
                        }
            }
        }
        LBAR();
        const int src_dn = (lane & 48) | ((fr + 15) & 15), src_up = (lane & 48) | ((fr + 1) & 15);
#pragma unroll
        for (int n = 0; n < 2; ++n) {
            const int ca = u.pn * 128 + tcol + 4 * n;
            f32x4 cw[2][4];
#pragma unroll
            for (int bj = 0; bj < 2; ++bj) { cw[bj][0] = *(const f32x4*)(convw + ca + bj * FF); cw[bj][1] = *(const f32x4*)(convw + FF2 + ca + bj * FF); cw[bj][2] = *(const f32x4*)(convw + 2 * FF2 + ca + bj * FF); cw[bj][3] = *(const f32x4*)(convb + ca + bj * FF); }
#pragma unroll
            for (int ai = 0; ai < 2; ++ai) {
                const int b = 2 * ai + wr;
                f32x4 cva[4], outv[4];
#pragma unroll
                for (int bj = 0; bj < 2; ++bj) {
                    f32x4 v[4];
#pragma unroll
                    for (int m = 0; m < 4; ++m) v[m] = acc[ai][bj][m][n] * rs[ai][m];
                    f32x4 prevv, nextv;
#pragma unroll
                    for (int i = 0; i < 4; ++i) {
                        prevv[i] = __uint_as_float((unsigned)__builtin_amdgcn_update_dpp(0, (int)__float_as_uint(v[3][i]), 0x111, 0xf, 0xf, false));
                        nextv[i] = __uint_as_float((unsigned)__builtin_amdgcn_update_dpp(0, (int)__float_as_uint(v[0][i]), 0x101, 0xf, 0xf, false));
                    }
                    if (fr == 0) prevv = *(const LAS f32x4*)(ex + (((b > 0 ? b - 1 : 0)) * 2 + 1) * 256 + bj * 128 + tcol + 4 * n);
                    if (fr == 15) nextv = *(const LAS f32x4*)(ex + (((b < 3 ? b + 1 : 3)) * 2 + 0) * 256 + bj * 128 + tcol + 4 * n);
#pragma unroll
                    for (int m = 0; m < 4; ++m) {
                        const f32x4 pv = m == 0 ? prevv : v[m > 0 ? m - 1 : 0], nv = m == 3 ? nextv : v[m < 3 ? m + 1 : 3];
                        const f32x4 cv = cw[bj][0] * pv + cw[bj][1] * v[m] + cw[bj][2] * nv + cw[bj][3];
                        if (bj == 0) cva[m] = cv;
                        else {
                            outv[m] = silu4(cva[m]) * cv;
                        }
                    }
                }
#pragma unroll
                for (int m = 0; m < 4; ++m) {
                    const int tr = ai * 128 + wr * 64 + 4 * fr + m;
                    if (tr != 0 && tr != 255) *(u32x2*)(ACT + (size_t)(u.pm * 256 + tr) * FF + ca) = pack4(outv[m]);
                }
                __builtin_amdgcn_sched_barrier(0);
            }
        }
    }
};

DI void tr_load(f32x4 (&v)[16], const float* W, int N, int kb, int nb, int lane) {
    const int k0 = 64 * kb, n0 = 64 * nb;
#pragma unroll
    for (int i = 0; i < 16; ++i) v[i] = __builtin_nontemporal_load((const f32x4*)(W + (size_t)(k0 + 4 * i + (lane >> 4)) * N + n0 + 4 * (lane & 15)));
}
template <bool SCALE> DI void tr_finish(const f32x4 (&v)[16], const float (&ks)[16], int K, bf16_t* WT, int mode, LAS float* scr, int kb, int nb, int lane) {
    const int k0 = 64 * kb, n0 = 64 * nb;
#pragma unroll
    for (int i = 0; i < 16; ++i) { const int kk = 4 * i + (lane >> 4); *(LAS f32x4*)(scr + kk * 68 + 4 * (lane & 15)) = SCALE ? v[i] * ks[i] : v[i]; }
    asm volatile("s_waitcnt lgkmcnt(0)" ::: "memory");
    const int ncol = n0 + lane;
    int prow = ncol; float sc = 1.f;
    if (mode == 1) { const int region = ncol >> 10; if (region < 2) { const int cc = ncol & 127; prow = (ncol & ~127) + 32 * ((cc >> 4) & 3) + 8 * ((cc >> 2) & 3) + 4 * (cc >> 6) + (cc & 3); if (region == 0) sc = 0.08838834764831845f; } }
    else if (mode == 2) { if (ncol < FF) prow = 256 * (ncol >> 7) + (ncol & 127); else { const int nn = ncol - FF; prow = 256 * (nn >> 7) + 128 + (nn & 127); } }
    bf16_t* orow = WT + (size_t)prow * K + k0;
#pragma unroll
    for (int j = 0; j < 8; ++j) {
        const LAS float* sp = scr + (8 * j) * 68 + lane;
        u32x4 o; o.x = cvt_pk_bf16(sp[0 * 68] * sc, sp[1 * 68] * sc); o.y = cvt_pk_bf16(sp[2 * 68] * sc, sp[3 * 68] * sc); o.z = cvt_pk_bf16(sp[4 * 68] * sc, sp[5 * 68] * sc); o.w = cvt_pk_bf16(sp[6 * 68] * sc, sp[7 * 68] * sc);
        *(u32x4*)(orow + 8 * j) = o;
    }
    asm volatile("s_waitcnt lgkmcnt(0)" ::: "memory");
}
template <bool SCALE> DI void tr_pair(const float* W, int K, int N, bf16_t* WT, const float* kscale, int mode, LAS float* scr, int kb0, int nb, int lane) {
    float ksa[16], ksb[16];
#pragma unroll
    for (int i = 0; i < 16; ++i) { ksa[i] = SCALE ? kscale[64 * kb0 + 4 * i + (lane >> 4)] : 1.f; ksb[i] = SCALE ? kscale[64 * kb0 + 64 + 4 * i + (lane >> 4)] : 1.f; }
    f32x4 va[16], vb[16];
    tr_load(va, W, N, kb0, nb, lane); tr_load(vb, W, N, kb0 + 1, nb, lane);
    tr_finish<SCALE>(va, ksa, K, WT, mode, scr, kb0, nb, lane);
    tr_finish<SCALE>(vb, ksb, K, WT, mode, scr, kb0 + 1, nb, lane);
}

typedef short s16x4 __attribute__((ext_vector_type(4)));
DI bf16x8 tr_frag(const LAS bf16_t* tile, int pitch, int tok0, int f0, int lane) {
    const int i = lane & 15, q = i >> 2, p = i & 3, fq = lane >> 4;
    LAS bf16_t* a = (LAS bf16_t*)tile + (tok0 + 8 * fq + q) * pitch + f0 + 4 * p;
    const s16x4 lo = __builtin_amdgcn_ds_read_tr16_b64_v4i16((LAS s16x4*)a);
    const s16x4 hi = __builtin_amdgcn_ds_read_tr16_b64_v4i16((LAS s16x4*)(a + 4 * pitch));
    return __builtin_shufflevector(lo, hi, 0, 1, 2, 3, 4, 5, 6, 7);
}
constexpr int VP = 40;

DI void scan_item(LAS unsigned char* lds, int item, const bf16_t* Z, bf16_t* crossF, bf16_t* crossB, const float* lgf, const float* lgb) {
    const int tid = threadIdx.x, lane = tid & 63, w = tid >> 6, fr = lane & 15, fq = lane >> 4;
    const int sidx = item >> 6, rem = item & 63, h = rem >> 3, dir = (rem >> 2) & 1, sl = rem & 3;
    const int rowbase = sidx == 0 ? 8192 : (sidx == 1 ? 0 : 4096), nch = sidx == 0 ? 64 : 32;
    const float l2g = (dir ? lgb[h] : lgf[h]) * LOG2E;
    const float decay = exp2f(l2g * 128.f);
    bf16_t* cross = dir ? crossB : crossF;
    LAS bf16_t* Qn = (LAS bf16_t*)lds; LAS bf16_t* Kn = Qn + 128 * TP; LAS bf16_t* Vn = Kn + 128 * TP; LAS bf16_t* Rt = Vn + 128 * VP;
    f32x4 racc[2]; racc[0] = (f32x4){0.f, 0.f, 0.f, 0.f}; racc[1] = racc[0];
    const int vr = tid >> 2, vc = tid & 3;
    const float zeta = exp2f(l2g * (float)(dir ? vr : 127 - vr));
    const int n = 16 * w + fr;
    const float xi = exp2f(l2g * (float)(dir ? 128 - n : n + 1));
    const bf16_t* zbase = Z + (size_t)rowbase * INC + h * 128;
    u32x4 qA[4], kA[4], vA, qB[4], kB[4], vB, qC[4], kC[4], vC, qD[4], kD[4], vD;
#define SC_LOAD(Q_, K_, V_, s_) do { const int c_ = dir ? nch - 1 - (s_) : (s_); const bf16_t* zb = zbase + (size_t)c_ * 128 * INC; \
        _Pragma("unroll") for (int i = 0; i < 4; ++i) { const int v = tid + 512 * i; Q_[i] = *(const u32x4*)(zb + (size_t)(v >> 4) * INC + (v & 15) * 8); K_[i] = *(const u32x4*)(zb + (size_t)(v >> 4) * INC + 1024 + (v & 15) * 8); } \
        V_ = *(const u32x4*)(zb + (size_t)vr * INC + 2048 + sl * 32 + vc * 8); } while (0)
#define SC_STEP(Q_, K_, V_, s_) do { const int c_ = dir ? nch - 1 - (s_) : (s_); const int row0 = rowbase + c_ * 128; \
        _Pragma("unroll") for (int i = 0; i < 4; ++i) { const int v = tid + 512 * i; *(LAS u32x4*)(Qn + (v >> 4) * TP + (v & 15) * 8) = Q_[i]; *(LAS u32x4*)(Kn + (v >> 4) * TP + (v & 15) * 8) = K_[i]; } \
        { u32x4 o; _Pragma("unroll") for (int e = 0; e < 4; ++e) o[e] = cvt_pk_bf16(bf_lo(V_[e]) * zeta, bf_hi(V_[e]) * zeta); *(LAS u32x4*)(Vn + vr * VP + vc * 8) = o; } \
        _Pragma("unroll") for (int t = 0; t < 2; ++t) *(LAS u32x2*)(Rt + (16 * t + fr) * TP + 16 * w + 4 * fq) = pack4(racc[t]); \
        LBAR(); \
        if ((s_) + 4 < nch) SC_LOAD(Q_, K_, V_, (s_) + 4); \
        bf16x8 qf[4]; \
        _Pragma("unroll") for (int ks = 0; ks < 4; ++ks) qf[ks] = *(const LAS bf16x8*)(Qn + n * TP + ks * 32 + fq * 8); \
        _Pragma("unroll") for (int t = 0; t < 2; ++t) { f32x4 ca = {0.f, 0.f, 0.f, 0.f}; \
            _Pragma("unroll") for (int ks = 0; ks < 4; ++ks) { const bf16x8 rf = *(const LAS bf16x8*)(Rt + (16 * t + fr) * TP + ks * 32 + fq * 8); ca = MFMA16(rf, qf[ks], ca); } \
            *(u32x2*)(cross + (size_t)(row0 + n) * RW + h * 128 + sl * 32 + 16 * t + 4 * fq) = pack4(ca * xi); } \
        racc[0] = racc[0] * decay; racc[1] = racc[1] * decay; \
        _Pragma("unroll") for (int ks = 0; ks < 4; ++ks) { const bf16x8 kf = tr_frag(Kn, TP, 32 * ks, 16 * w, lane); \
            _Pragma("unroll") for (int t = 0; t < 2; ++t) { const bf16x8 vf = tr_frag(Vn, VP, 32 * ks, 16 * t, lane); racc[t] = MFMA16(kf, vf, racc[t]); } } \
        LBAR(); } while (0)
    SC_LOAD(qA, kA, vA, 0); SC_LOAD(qB, kB, vB, 1); SC_LOAD(qC, kC, vC, 2); SC_LOAD(qD, kD, vD, 3);
    for (int step = 0; step < nch; step += 4) { SC_STEP(qA, kA, vA, step); SC_STEP(qB, kB, vB, step + 1); SC_STEP(qC, kC, vC, step + 2); SC_STEP(qD, kD, vD, step + 3); }
#undef SC_LOAD
#undef SC_STEP
}

DI void sgu_item(LAS unsigned char* lds, int item, const bf16_t* Z, const float* ssqv, const float* normw, const bf16_t* wsb, const float* sgub, bf16_t* MIX) {
    const int tid = threadIdx.x, lane = tid & 63, w = tid >> 6, fr = lane & 15, fq = lane >> 4;
    const int chunk = item >> 3, g = item & 7, row0 = chunk * 128;
    LAS bf16_t* Wsl = (LAS bf16_t*)lds; LAS bf16_t* vt = Wsl + 128 * TP;
    const int tr = tid & 127, tc = tid >> 7;
    u32x4 wv[4], zv[4]; f32x4 nw[4][2];
#pragma unroll
    for (int i = 0; i < 4; ++i) { const int v = tid + 512 * i; wv[i] = *(const u32x4*)(wsb + (size_t)g * 16384 + (size_t)v * 8); }
#pragma unroll
    for (int i = 0; i < 4; ++i) { const int c8 = tc + 4 * i; zv[i] = *(const u32x4*)(Z + (size_t)(row0 + tr) * INC + 5 * 1024 + g * 128 + c8 * 8);
        nw[i][0] = *(const f32x4*)(normw + g * 128 + c8 * 8); nw[i][1] = *(const f32x4*)(normw + g * 128 + c8 * 8 + 4); }
    const f32x4* sp = (const f32x4*)(ssqv + (size_t)(row0 + tr) * 16);
    const float ss = sum4(sp[0]) + sum4(sp[1]) + sum4(sp[2]) + sum4(sp[3]);
    const int n = 16 * w + fr, row = row0 + n;
    const float bn = sgub[g * 128 + n];
    u32x2 uu[8];
#pragma unroll
    for (int db = 0; db < 8; ++db) uu[db] = *(const u32x2*)(Z + (size_t)row * INC + 4 * 1024 + g * 128 + 16 * db + 4 * fq);
    const float rsv = rsqrtf(ss * (1.0f / 1024.f) + EPS);
#pragma unroll
    for (int i = 0; i < 4; ++i) { const int v = tid + 512 * i; *(LAS u32x4*)(Wsl + (v >> 4) * TP + (v & 15) * 8) = wv[i]; }
#pragma unroll
    for (int i = 0; i < 4; ++i) {
        const int c8 = tc + 4 * i;
#pragma unroll
        for (int e = 0; e < 8; e += 2) {
            const unsigned wd = zv[i][e >> 1]; const float s0 = nw[i][e >> 2][e & 3] * rsv, s1 = nw[i][e >> 2][(e + 1) & 3] * rsv;
            const unsigned pk = cvt_pk_bf16(bf_lo(wd) * s0, bf_hi(wd) * s1);
            vt[(c8 * 8 + e) * TP + tr] = (unsigned short)(pk & 0xffffu); vt[(c8 * 8 + e + 1) * TP + tr] = (unsigned short)(pk >> 16);
        }
    }
    LBAR();
    bf16x8 wf[4];
#pragma unroll
    for (int ks = 0; ks < 4; ++ks) wf[ks] = *(const LAS bf16x8*)(Wsl + n * TP + ks * 32 + fq * 8);
#pragma unroll
    for (int db = 0; db < 8; ++db) {
        f32x4 s = {0.f, 0.f, 0.f, 0.f};
#pragma unroll
        for (int ks = 0; ks < 4; ++ks) { const bf16x8 vf = *(const LAS bf16x8*)(vt + (16 * db + fr) * TP + ks * 32 + fq * 8); s = MFMA16(vf, wf[ks], s); }
        const int col = g * 128 + 16 * db + 4 * fq;
        f32x4 o; o[0] = bf_lo(uu[db].x) * (s[0] + bn); o[1] = bf_hi(uu[db].x) * (s[1] + bn); o[2] = bf_lo(uu[db].y) * (s[2] + bn); o[3] = bf_hi(uu[db].y) * (s[3] + bn);
        *(u32x2*)(MIX + (size_t)row * DM + 1024 + col) = pack4(o);
    }
    LBAR();
}

DI void inner_phase(LAS unsigned char* lds, int bid, int G, const bf16_t* Z, const bf16_t* crossF, const bf16_t* crossB, const float* gnw, const float* lgf, const float* lgb, bf16_t* MIX) {
    const int tid = threadIdx.x, lane = tid & 63, w = tid >> 6, fr = lane & 15, fq = lane >> 4;
    LAS bf16_t* Qs = (LAS bf16_t*)lds; LAS bf16_t* Ks = Qs + 128 * TP; LAS bf16_t* Vt = Ks + 128 * TP;
    const int tr = tid & 127, tc = tid >> 7;
    u32x4 qr[4], kr[4], vr[4];
#define IN_LOAD(it_) do { const bf16_t* zb = Z + (size_t)((it_) >> 3) * 128 * INC + ((it_) & 7) * 128; \
        _Pragma("unroll") for (int i = 0; i < 4; ++i) { const int v = tid + 512 * i; const bf16_t* zp = zb + (size_t)(v >> 4) * INC + (v & 15) * 8; qr[i] = *(const u32x4*)zp; kr[i] = *(const u32x4*)(zp + 1024); \
            vr[i] = *(const u32x4*)(zb + (size_t)tr * INC + 2048 + (tc + 4 * i) * 8); } } while (0)
    if (bid < 1024) IN_LOAD(bid);
    for (int item = bid; item < 1024; item += G) {
        const int chunk = item >> 3, h = item & 7, row0 = chunk * 128;
#pragma unroll
        for (int i = 0; i < 4; ++i) { const int v = tid + 512 * i; const int o = (v >> 4) * TP + (v & 15) * 8; *(LAS u32x4*)(Qs + o) = qr[i]; *(LAS u32x4*)(Ks + o) = kr[i];
#pragma unroll
            for (int e = 0; e < 8; ++e) { const int c8 = tc + 4 * i; Vt[(32 * (c8 >> 2) + 16 * (e >> 2) + 4 * (c8 & 3) + (e & 3)) * TP + tr] = u16_of(vr[i], e); } }
        LBAR();
        const float l2f = lgf[h] * LOG2E, l2b = lgb[h] * LOG2E;
        const int n = 16 * w + fr, row = row0 + n;
        u32x4 cf[4], cb[4], gg[4];
#pragma unroll
        for (int a4 = 0; a4 < 4; ++a4) { const int col = h * 128 + 32 * a4 + 8 * fq; cf[a4] = *(const u32x4*)(crossF + (size_t)row * RW + col); cb[a4] = *(const u32x4*)(crossB + (size_t)row * RW + col);
            gg[a4] = *(const u32x4*)(Z + (size_t)row * INC + 3 * 1024 + col); }
        asm volatile("" ::: "memory");
        if (item + G < 1024) IN_LOAD(item + G);
        bf16x8 qf[4];
#pragma unroll
        for (int ks = 0; ks < 4; ++ks) qf[ks] = *(const LAS bf16x8*)(Qs + n * TP + ks * 32 + fq * 8);
        asm volatile("s_waitcnt lgkmcnt(0)" ::: "memory");
#pragma unroll
        for (int mb = 0; mb < 8; ++mb) {
            f32x4 s = {0.f, 0.f, 0.f, 0.f};
#pragma unroll
            for (int ks = 0; ks < 4; ++ks) { const bf16x8 kf = *(const LAS bf16x8*)(Ks + (16 * mb + fr) * TP + ks * 32 + fq * 8); s = MFMA16(kf, qf[ks], s); }
#pragma unroll
            for (int r = 0; r < 4; ++r) { const int d = n - (16 * mb + 4 * fq + r); s[r] *= d >= 0 ? exp2f(l2f * (float)d) : exp2f(l2b * (float)(-d)); }
            *(LAS u32x2*)(Qs + n * TP + 16 * mb + 4 * fq) = pack4(s);
        }
        asm volatile("s_waitcnt lgkmcnt(0)" ::: "memory");
        bf16x8 wf[4];
#pragma unroll
        for (int ks = 0; ks < 4; ++ks) wf[ks] = *(const LAS bf16x8*)(Qs + n * TP + ks * 32 + fq * 8);
        f32x4 o[8]; float sm = 0.f;
#pragma unroll
        for (int eb = 0; eb < 8; ++eb) {
            f32x4 a = {0.f, 0.f, 0.f, 0.f};
#pragma unroll
            for (int ks = 0; ks < 4; ++ks) { const bf16x8 vf = *(const LAS bf16x8*)(Vt + (16 * eb + fr) * TP + ks * 32 + fq * 8); a = MFMA16(vf, wf[ks], a); }
            { const unsigned f0 = cf[eb >> 1][2 * (eb & 1)], f1 = cf[eb >> 1][2 * (eb & 1) + 1], b0 = cb[eb >> 1][2 * (eb & 1)], b1 = cb[eb >> 1][2 * (eb & 1) + 1];
              a[0] += bf_lo(f0) + bf_lo(b0); a[1] += bf_hi(f0) + bf_hi(b0); a[2] += bf_lo(f1) + bf_lo(b1); a[3] += bf_hi(f1) + bf_hi(b1); }
            o[eb] = a; sm += sum4(a);
        }
        sm += __shfl_xor(sm, 16); sm += __shfl_xor(sm, 32);
        const float mean = sm * (1.0f / 128.f); float vs = 0.f;
#pragma unroll
        for (int eb = 0; eb < 8; ++eb) { o[eb] = o[eb] - mean; vs += sq4(o[eb]); }
        vs += __shfl_xor(vs, 16); vs += __shfl_xor(vs, 32);
        const float rstd = rsqrtf(vs * (1.0f / 128.f) + EPS);
#pragma unroll
        for (int a4 = 0; a4 < 4; ++a4) {
            const int col = h * 128 + 32 * a4 + 8 * fq;
            const f32x4 gw0 = *(const f32x4*)(gnw + col), gw1 = *(const f32x4*)(gnw + col + 4);
            const u32x4 g4 = gg[a4]; const f32x4 o0 = o[2 * a4], o1 = o[2 * a4 + 1];
            f32x4 r0, r1;
            r0[0] = bf_lo(g4.x) * (o0[0] * rstd * gw0[0]); r0[1] = bf_hi(g4.x) * (o0[1] * rstd * gw0[1]); r0[2] = bf_lo(g4.y) * (o0[2] * rstd * gw0[2]); r0[3] = bf_hi(g4.y) * (o0[3] * rstd * gw0[3]);
            r1[0] = bf_lo(g4.z) * (o1[0] * rstd * gw1[0]); r1[1] = bf_hi(g4.z) * (o1[1] * rstd * gw1[1]); r1[2] = bf_lo(g4.w) * (o1[2] * rstd * gw1[2]); r1[3] = bf_hi(g4.w) * (o1[3] * rstd * gw1[3]);
            u32x4 w4; w4.x = cvt_pk_bf16(r0[0], r0[1]); w4.y = cvt_pk_bf16(r0[2], r0[3]); w4.z = cvt_pk_bf16(r1[0], r1[1]); w4.w = cvt_pk_bf16(r1[2], r1[3]);
            *(u32x4*)(MIX + (size_t)row * DM + col) = w4;
        }
        LBAR();
    }
#undef IN_LOAD
}

struct Args { const float* in[17]; float* out; unsigned char* ws; };

#define XB_TMO      128
#define XB_XCNT(j)  (256  + 64 * (j))
#define XB_XSUB(j)  (1280 + 64 * (j))
#define XB_XGEN(j)  (2304 + 64 * (j))
#define XB_TOP      3328
#define XB_TOPGEN   3392
#define XCD_BAR_WORDS 3456
#define XB_SPIN_CAP (1u << 18)

__device__ __forceinline__ unsigned xb_ld(unsigned* p)              { return __hip_atomic_load(p, __ATOMIC_RELAXED, __HIP_MEMORY_SCOPE_AGENT); }
__device__ __forceinline__ unsigned xb_add(unsigned* p, unsigned v) { return __hip_atomic_fetch_add(p, v, __ATOMIC_RELAXED, __HIP_MEMORY_SCOPE_AGENT); }
__device__ __forceinline__ unsigned xb_xcc_id() { return (unsigned)__builtin_amdgcn_s_getreg((3 << 11) | 20) & 0xFu; }
#define XB_SPIN(cond, bar) do { unsigned _sp = 0; while (cond) { __builtin_amdgcn_s_sleep(1); \
    if ((++_sp & 255u) == 0u) { if (xb_ld(&(bar)[XB_TMO])) break; if (_sp > XB_SPIN_CAP) { atomicAdd(&(bar)[XB_TMO], 1u); break; } } } } while (0)

struct XcdBarrier {
    unsigned* bar; unsigned x;
    volatile LAS unsigned* st;
};

__device__ __forceinline__ XcdBarrier xcd_barrier_post(unsigned* bar, volatile LAS unsigned* st) {
    XcdBarrier b; b.bar = bar; b.x = xb_xcc_id(); b.st = st;
    if (threadIdx.x == 0) (void)xb_add(&bar[XB_XCNT(b.x)], 1u);
    return b;
}
__device__ __forceinline__ void xcd_barrier_complete(unsigned* bar, unsigned x, unsigned& nloc, unsigned& nx) {
    const unsigned G = gridDim.x * gridDim.y * gridDim.z;
    unsigned sum, cnt, mine, sp = 0u;
    for (;;) {
        sum = 0u; cnt = 0u; mine = 0u;
#pragma unroll
        for (unsigned j = 0; j < 16; ++j) { const unsigned c = xb_ld(&bar[XB_XCNT(j)]); sum += c; cnt += (c > 0u) ? 1u : 0u; mine = (j == x) ? c : mine; }
        if (sum == G) break;
        __builtin_amdgcn_s_sleep(1);
        if ((++sp & 255u) == 0u) { if (xb_ld(&bar[XB_TMO])) break; if (sp > XB_SPIN_CAP) { atomicAdd(&bar[XB_TMO], 1u); break; } }
    }
    nloc = mine > 0u ? mine : 1u; nx = cnt > 0u ? cnt : 1u;
}

__device__ __forceinline__ void xcd_barrier(const XcdBarrier& b) {
    asm volatile("s_waitcnt vmcnt(0)" ::: "memory");
    __syncthreads();
    if (threadIdx.x == 0) {
        unsigned* bar = b.bar;
        __builtin_amdgcn_s_waitcnt(0);
        unsigned nloc = b.st[0], nx = b.st[1];
        if (nloc == 0u) { xcd_barrier_complete(bar, b.x, nloc, nx); b.st[0] = nloc; b.st[1] = nx; }
        const unsigned old = xb_add(&bar[XB_XSUB(b.x)], 1u);
        const unsigned gen = old / nloc;
        if (old + 1u == (gen + 1u) * nloc) {
            __builtin_amdgcn_fence(__ATOMIC_RELEASE, "agent");
            asm volatile("s_waitcnt vmcnt(0)" ::: "memory");
            const unsigned og = xb_add(&bar[XB_TOP], 1u);
            const unsigned tg = og / nx;
            if (og + 1u == (tg + 1u) * nx) xb_add(&bar[XB_TOPGEN], 1u);
            else XB_SPIN(xb_ld(&bar[XB_TOPGEN]) == tg, bar);
            __builtin_amdgcn_fence(__ATOMIC_ACQUIRE, "agent");
            xb_add(&bar[XB_XGEN(b.x)], 1u);
            asm volatile("s_waitcnt vmcnt(0)" ::: "memory");
        } else {
            XB_SPIN(xb_ld(&bar[XB_XGEN(b.x)]) == gen, bar);
            __builtin_amdgcn_fence(__ATOMIC_ACQUIRE, "agent");
            asm volatile("s_waitcnt vmcnt(0)" ::: "memory");
        }
    }
    __syncthreads();
}

#if REP_MASK
#define STAMP(k) do { if (blockIdx.x == 0 && threadIdx.x == 0) ((volatile LAS unsigned*)(lds + MISC_OFF + 64))[k] = (unsigned)__builtin_amdgcn_s_memrealtime(); } while (0)
#else
#define STAMP(k) do { } while (0)
#endif
__global__ void __launch_bounds__(512, 2) fwd_kernel(Args a) {
    extern __shared__ __attribute__((aligned(16))) unsigned char lds_raw[];
    LAS unsigned char* lds = (LAS unsigned char*)lds_raw;
    const int tid = threadIdx.x, lane = tid & 63, wave = __builtin_amdgcn_readfirstlane(tid >> 6);
    const int G = gridDim.x, bid = blockIdx.x;
    unsigned char* ws = a.ws;
    const float* xp = a.in[0]; const float* xs = a.in[1];
    bf16_t* Win_t = (bf16_t*)(ws + WS_WIN); bf16_t* Wout_t = (bf16_t*)(ws + WS_WOUT); bf16_t* Wup_t = (bf16_t*)(ws + WS_WUP); bf16_t* Wdown_t = (bf16_t*)(ws + WS_WDOWN);
    bf16_t* Zb = (bf16_t*)(ws + WS_Z); bf16_t* X1B = (bf16_t*)(ws + WS_X1B); bf16_t* ACT = (bf16_t*)(ws + WS_ACT); bf16_t* MIX = (bf16_t*)(ws + WS_MIX);
    float* HALO = (float*)(ws + WS_HALO); float* ROPE = (float*)(ws + WS_ROPE); float* RS1 = (float*)(ws + WS_RS1);
    float* SSQV = (float*)(ws + WS_SSQV); float* SSQ2 = (float*)(ws + WS_SSQ2); float* SSQ3 = (float*)(ws + WS_SSQ3);
    unsigned* CTL = (unsigned*)(ws + WS_CTL);
    bf16_t* X2B = (bf16_t*)(ws + WS_X1B);
    bf16_t* WSB = (bf16_t*)(ws + 335 * MiB);
    { volatile LAS unsigned* st_ = (volatile LAS unsigned*)(lds + MISC_OFF + 128); if (tid == 0) { st_[0] = 0u; st_[1] = 0u; } }
    __syncthreads();
    const XcdBarrier xbar = xcd_barrier_post(CTL + 1024, (volatile LAS unsigned*)(lds + MISC_OFF + 128));
    bf16_t* XB = (bf16_t*)a.out; bf16_t* crossF = (bf16_t*)a.out + (size_t)T * DM; bf16_t* crossB = crossF + (size_t)T * RW; float* X1 = a.out;

    STAMP(0);
    if (PH_MASK & 1) {
        LAS float* scr = (LAS float*)(lds + wave * 17408);
        const int gw = bid * 8 + wave, NGW = G * 8;
        for (int it = gw; it < (DM / 128) * (INC / 64); it += NGW) tr_pair<true>(a.in[3], DM, INC, Win_t, a.in[2], 1, scr, 2 * (it / (INC / 64)), it % (INC / 64), lane);
        for (int row = gw; row < T; row += 2 * NGW) {
            const int row2 = row + NGW;
            const float* xr = row < 8192 ? xp + (size_t)row * DM : xs + (size_t)(row - 8192) * DM;
            const float* xr2 = row2 < 8192 ? xp + (size_t)row2 * DM : xs + (size_t)(row2 - 8192) * DM;
            f32x4 v[8], u[8]; float s = 0.f, s2 = 0.f;
#pragma unroll
            for (int j = 0; j < 8; ++j) v[j] = __builtin_nontemporal_load((const f32x4*)(xr + 256 * j + 4 * lane));
#pragma unroll
            for (int j = 0; j < 8; ++j) u[j] = __builtin_nontemporal_load((const f32x4*)(xr2 + 256 * j + 4 * lane));
#pragma unroll
            for (int j = 0; j < 8; ++j) { s += sq4(v[j]); s2 += sq4(u[j]); }
            s = wave_sum(s); s2 = wave_sum(s2);
            if (lane == 0) { RS1[row] = rsqrtf(s * (1.0f / DM) + EPS); RS1[row2] = rsqrtf(s2 * (1.0f / DM) + EPS); }
#pragma unroll
            for (int j = 0; j < 8; ++j) { *(u32x2*)(XB + (size_t)row * DM + 256 * j + 4 * lane) = pack4(v[j]); *(u32x2*)(XB + (size_t)row2 * DM + 256 * j + 4 * lane) = pack4(u[j]); }
        }
        for (int e = bid * 512 + tid; e < 8 * 128 * 128 / 4; e += G * 512) *(u32x2*)(WSB + 4 * (size_t)e) = pack4(*(const f32x4*)(a.in[8] + 4 * (size_t)e));
        const float inv = (float)exp2(-(double)(tid & 63) * (13.287712379549449 / 64.0));
        for (int e = bid * 512 + tid; e < 8192 * 64; e += G * 512) {
            const int pos = e >> 6;
            const float ang = (float)pos * inv;
            double rev = (double)ang * 0.15915494309189535; rev -= floor(rev);
            const float fr_ = (float)rev;
            ROPE[2 * e] = __builtin_amdgcn_cosf(fr_); ROPE[2 * e + 1] = __builtin_amdgcn_sinf(fr_);
        }
    }
    xcd_barrier(xbar); STAMP(1);

    if (PH_MASK & 2) {
        pg8::Gemm g{XB, Win_t, T, INC, DM}; pg8::StaticOrder S; S.init(T, INC, G, bid);
        EpiIn E{Zb, RS1, ROPE, SSQV};
        pg8::gemm_phase<EpiIn, pg8::StaticOrder, true, true>(lds, g, S, E);
    }
    xcd_barrier(xbar); STAMP(2);

    if (PH_MASK & 4) {
        volatile LAS int* sh = (volatile LAS int*)(lds + MISC_OFF);
        int pending = -1;
        if (bid < 192) { const int x_ = bid & 7, j_ = bid >> 3, grp_ = j_ >> 2; pending = (grp_ >> 1) * 64 + x_ * 8 + (grp_ & 1) * 4 + (j_ & 3); }
        for (;;) {
            if (pending < 0) {
                if (tid == 0) sh[0] = 192 + (int)atomicAdd(CTL, 1u);
                __syncthreads();
                pending = sh[0];
                __syncthreads();
            }
            const int item = pending; pending = -1;
            if (item >= 192 + 1024 + TR_ITEMS) break;
            if (item < 192) scan_item(lds, item, Zb, crossF, crossB, a.in[4], a.in[5]);
            else if (item >= 192 + TR_ITEMS) sgu_item(lds, item - (192 + TR_ITEMS), Zb, SSQV, a.in[7], WSB, a.in[9], MIX);
            else {
                int r = item - 192; LAS float* scr = (LAS float*)(lds + wave * 17408);
                int lane_ = lane; asm volatile("" : "+v"(lane_));
                if (r < TR_OUT) tr_pair<false>(a.in[10], DM, DM, Wout_t, nullptr, 0, scr, 2 * (r >> 2), (r & 3) * 8 + wave, lane_);
                else if ((r -= TR_OUT) < TR_UP) tr_pair<true>(a.in[12], DM, FF2, Wup_t, a.in[11], 2, scr, 2 * (r / 22), (r % 22) * 8 + wave, lane_);
                else { r -= TR_UP; tr_pair<false>(a.in[15], FF, DM, Wdown_t, nullptr, 0, scr, 2 * (r >> 2), (r & 3) * 8 + wave, lane_); }
            }
        }
    }
    xcd_barrier(xbar); STAMP(3);

    if (PH_MASK & 8) inner_phase(lds, bid, G, Zb, crossF, crossB, a.in[6], a.in[4], a.in[5], MIX);
    xcd_barrier(xbar); STAMP(4);

    if (PH_MASK & 16) {
        pg8::Gemm g{MIX, Wout_t, T, DM, DM}; pg8::StaticOrder S; S.init(T, DM, G, bid);
        EpiRes<false> E{(const float*)XB, nullptr, X1, X1B, SSQ2};
        pg8::gemm_phase<EpiRes<false>, pg8::StaticOrder, true, true>(lds, g, S, E);
    }
    xcd_barrier(xbar); STAMP(5);

    if (PH_MASK & 32) {
        pg8::Gemm g{X1B, Wup_t, T, FF2, DM}; pg8::StaticOrder S; S.init(T, FF2, G, bid);
        EpiUp E{ACT, HALO, SSQ2, a.in[13], a.in[14], (LAS float*)(lds + EX_OFF)};
        pg8::gemm_phase<EpiUp, pg8::StaticOrder, true, true>(lds, g, S, E);
    }
    xcd_barrier(xbar); STAMP(6);

    if (PH_MASK & 64) {
        const float* cw = a.in[13]; const float* cb = a.in[14];
        for (int e = bid * 512 + tid; e < 128 * FF; e += G * 512) {
            const int idx = e / FF, c = e - idx * FF, p = idx >> 1, which = idx & 1;
            const int row = p * 256 + (which ? 255 : 0);
            const bool first = (row == 0) || (row == 4096) || (row == 8192), last = (row == 4095) || (row == 8191) || (row == 16383);
            const int pa = 256 * (c >> 7) + (c & 127), pb = pa + 128;
            const float* hp = HALO + (size_t)(p * 4) * FF2;
            float pra, prb, cua, cub, nxa, nxb;
            if (which == 0) {
                pra = first ? 0.f : hp[-(ptrdiff_t)FF2 + pa]; prb = first ? 0.f : hp[-(ptrdiff_t)FF2 + pb];
                cua = hp[pa]; cub = hp[pb]; nxa = hp[FF2 + pa]; nxb = hp[FF2 + pb];
            } else {
                pra = hp[2 * FF2 + pa]; prb = hp[2 * FF2 + pb]; cua = hp[3 * FF2 + pa]; cub = hp[3 * FF2 + pb];
                nxa = last ? 0.f : hp[4 * (size_t)FF2 + pa]; nxb = last ? 0.f : hp[4 * (size_t)FF2 + pb];
            }
            const float va = cw[c] * pra + cw[FF2 + c] * cua + cw[2 * FF2 + c] * nxa + cb[c];
            const float vb = cw[FF + c] * prb + cw[FF2 + FF + c] * cub + cw[2 * FF2 + FF + c] * nxb + cb[FF + c];
            ACT[(size_t)row * FF + c] = (bf16_t)(cvt_pk_bf16(silu_f(va) * vb, 0.f) & 0xffffu);
        }
    }
    xcd_barrier(xbar); STAMP(7);

    if (PH_MASK & 128) {
        pg8::Gemm g{ACT, Wdown_t, T, DM, FF}; pg8::StaticOrder S; S.init(T, DM, G, bid);
        EpiRes<true> E{nullptr, nullptr, (float*)X2B, X1B, SSQ3};
        pg8::gemm_phase<EpiRes<true>, pg8::StaticOrder, true, true>(lds, g, S, E);
    }
    xcd_barrier(xbar); STAMP(8);

    if (PH_MASK & 256) {
        const int gw = bid * 8 + wave, NGW = G * 8; const float* fw = a.in[16];
        for (int row = gw; row < T; row += NGW) {
            float s = lane < 32 ? SSQ3[(size_t)row * 32 + lane] : 0.f;
            s = wave_sum(s);
            const float rs = rsqrtf(s * (1.0f / DM) + EPS);
            float* orow = a.out + (size_t)row * DM; const bf16_t* xrow = X2B + (size_t)row * DM;
#pragma unroll
            for (int j = 0; j < 4; ++j) { const u32x4 xb = __builtin_nontemporal_load((const u32x4*)(xrow + 512 * j + 8 * lane)); const f32x4 w0 = *(const f32x4*)(fw + 512 * j + 8 * lane), w1 = *(const f32x4*)(fw + 512 * j + 8 * lane + 4);
                f32x4 o0, o1; o0[0] = bf_lo(xb.x) * rs * w0[0]; o0[1] = bf_hi(xb.x) * rs * w0[1]; o0[2] = bf_lo(xb.y) * rs * w0[2]; o0[3] = bf_hi(xb.y) * rs * w0[3];
                o1[0] = bf_lo(xb.z) * rs * w1[0]; o1[1] = bf_hi(xb.z) * rs * w1[1]; o1[2] = bf_lo(xb.w) * rs * w1[2]; o1[3] = bf_hi(xb.w) * rs * w1[3];
                __builtin_nontemporal_store(o0, (f32x4*)(orow + 512 * j + 8 * lane)); __builtin_nontemporal_store(o1, (f32x4*)(orow + 512 * j + 8 * lane + 4)); }
        }
    }
#if REP_MASK
    STAMP(9);
    if (blockIdx.x == 0 && threadIdx.x == 0) {
        volatile LAS unsigned* tsv = (volatile LAS unsigned*)(lds + MISC_OFF + 64);
        unsigned dt = 0;
#pragma unroll
        for (int k = 0; k < 9; ++k) if ((REP_MASK >> k) & 1) dt += tsv[k + 1] - tsv[k];
        const unsigned t0 = (unsigned)__builtin_amdgcn_s_memrealtime();
        while ((unsigned)__builtin_amdgcn_s_memrealtime() - t0 < dt) __builtin_amdgcn_s_sleep(8);
    }
#endif
}

extern "C" void kernel_launch(void* const* d_in, const int* in_sizes, int n_in, void* d_out, int out_size, void* d_ws, size_t ws_size, hipStream_t stream) {
    static int grid = 0;
    if (grid == 0) {
        if (n_in != 17 || out_size != 2 * T / 2 * DM || ws_size < WS_END) { fprintf(stderr, "kernel_launch: unexpected sizes n_in %d out %d ws %zu (need %zu)\n", n_in, out_size, ws_size, (size_t)WS_END); grid = -1; }
        else {
            int dev = 0, cus = 0, per_cu = 0;
            (void)hipGetDevice(&dev); (void)hipDeviceGetAttribute(&cus, hipDeviceAttributeMultiprocessorCount, dev);
            (void)hipFuncSetAttribute((const void*)fwd_kernel, hipFuncAttributeMaxDynamicSharedMemorySize, LDS_BYTES);
            (void)hipOccupancyMaxActiveBlocksPerMultiprocessor(&per_cu, (const void*)fwd_kernel, 512, LDS_BYTES);
            if (per_cu < 1 || cus < 1) { fprintf(stderr, "kernel_launch: occupancy query says %d blocks/CU on %d CUs\n", per_cu, cus); grid = -1; }
            else grid = cus;
        }
    }
    if (grid < 0) { (void)hipMemsetAsync(d_out, 0, (size_t)out_size * 4, stream); return; }
    (void)hipMemsetAsync((char*)d_ws + WS_CTL, 0, 65536, stream);
    Args a{};
    for (int i = 0; i < 17; ++i) a.in[i] = (const float*)d_in[i];
    a.out = (float*)d_out; a.ws = (unsigned char*)d_ws;
    void* kargs[] = {&a};
    const hipError_t e = hipLaunchCooperativeKernel((const void*)fwd_kernel, dim3(grid), dim3(512), kargs, LDS_BYTES, stream);
    if (e != hipSuccess) fprintf(stderr, "kernel_launch: cooperative launch failed: %s (grid %d)\n", hipGetErrorString(e), grid);
}
```
